# Optimizing an MI355X kernel written in HIP

```python
import math, functools
import jax, jax.numpy as jnp
from jax import lax
import numpy as np

D_MODEL = 2048
BATCH = 1
SEQ = 8192
DEPTH = 1
DEC_BATCH = 128
DEC_SEQ = 1
PAST_LEN = 8192
PAGE_SIZE = 128

D_MIX = D_MODEL
D_RNN = D_MIX // 2
N_RNN_BLOCKS = 16
RNN_BLOCK = D_RNN // N_RNN_BLOCKS
RNN_CONV = 4
LRU_C = 8.0
N_HEADS = 8
HEAD_DIM = 128
N_KV = 2
GROUP = N_HEADS // N_KV
D_ATTN = N_HEADS * HEAD_DIM
WINDOW = 128
BLOCK = 128
NUM_BUCKETS = 32
MAX_DISTANCE = 128
D_FF = 3 * D_MODEL
FFN_CONV = 3
N_META = 16
EPS = 1e-6
NEG = -1e30
D_IN = 2 * D_RNN + D_ATTN + 2 * N_KV * HEAD_DIM

kernel_name = "hymba_rglru_swa_sink_convffn_step"


def rmsnorm(x, g):
    xf = x.astype(jnp.float32)
    y = xf * lax.rsqrt(jnp.mean(xf * xf, axis=-1, keepdims=True) + EPS)
    return (y * g.astype(jnp.float32)).astype(x.dtype)


def causal_dwconv(x_hist, w, b):
    width = w.shape[0]
    t = x_hist.shape[1] - width + 1
    out = b
    for j in range(width):
        out = out + x_hist[:, j:j + t] * w[j]
    return out


def _lin_comb(left, right):
    a1, b1 = left
    a2, b2 = right
    return a1 * a2, a2 * b1 + b2


def rglru(xc, h0, gate_a_w, gate_a_b, gate_x_w, gate_x_b, rnn_lambda):
    bsz, t, _ = xc.shape
    xb = xc.reshape(bsz, t, N_RNN_BLOCKS, RNN_BLOCK)
    r = jax.nn.sigmoid((jnp.einsum('btnc,ncd->btnd', xb, gate_a_w).reshape(bsz, t, D_RNN) + gate_a_b).astype(jnp.float32))
    i = jax.nn.sigmoid((jnp.einsum('btnc,ncd->btnd', xb, gate_x_w).reshape(bsz, t, D_RNN) + gate_x_b).astype(jnp.float32))
    log_a = -LRU_C * r * jax.nn.softplus(-rnn_lambda.astype(jnp.float32))
    a = jnp.exp(log_a)
    b = jnp.sqrt(-jnp.expm1(2.0 * log_a)) * i * xc.astype(jnp.float32)
    a_cum, b_cum = lax.associative_scan(_lin_comb, (a, b), axis=1)
    h = a_cum * h0.astype(jnp.float32)[:, None] + b_cum
    return h.astype(xc.dtype), h[:, -1].astype(xc.dtype)


def rel_bucket(d):
    d = jnp.maximum(d, 0)
    exact = NUM_BUCKETS // 2
    large = exact + (jnp.log(jnp.maximum(d, 1).astype(jnp.float32) / exact)
                     / math.log(MAX_DISTANCE / exact) * (NUM_BUCKETS - exact)).astype(jnp.int32)
    large = jnp.minimum(large, NUM_BUCKETS - 1)
    return jnp.where(d < exact, d, large)


def rel_bias(d, table):
    q, s = d.shape
    bias = table[rel_bucket(d)].astype(jnp.float32)
    return bias.reshape(q, s, N_KV, GROUP).transpose(2, 3, 0, 1)


def sink_softmax(logits, sinks):
    sink = jnp.broadcast_to(sinks.astype(jnp.float32).reshape(N_KV, GROUP, 1, 1), logits.shape[:-1] + (1,))
    p = jax.nn.softmax(jnp.concatenate([logits, sink], axis=-1), axis=-1)
    return p[..., :-1]


def window_attn_prompt(q, k, v, sinks, table):
    bsz, t = q.shape[:2]
    p_front = (-N_META) % BLOCK
    p_end = (-(t + p_front)) % BLOCK
    pad = ((0, 0), (p_front, p_end), (0, 0), (0, 0))
    qp, kp, vp = jnp.pad(q, pad), jnp.pad(k, pad), jnp.pad(v, pad)
    tp = t + p_front + p_end
    nb = tp // BLOCK
    qb = qp.reshape(bsz, nb, BLOCK, N_KV, GROUP, HEAD_DIM)
    kb = kp.reshape(bsz, nb, BLOCK, N_KV, HEAD_DIM)
    vb = vp.reshape(bsz, nb, BLOCK, N_KV, HEAD_DIM)
    shift = ((0, 0), (1, 0), (0, 0), (0, 0), (0, 0))
    kk = jnp.concatenate([jnp.pad(kb, shift)[:, :-1], kb], axis=2)
    vv = jnp.concatenate([jnp.pad(vb, shift)[:, :-1], vb], axis=2)
    qi = jnp.arange(BLOCK)
    sj = jnp.arange(2 * BLOCK)
    d = BLOCK + qi[:, None] - sj[None, :]
    band = (d >= 0) & (d < WINDOW)
    kidx = jnp.arange(nb)[:, None] * BLOCK - BLOCK + sj[None, :]
    mask = band[None] & (kidx >= p_front)[:, None, :]
    logits = jnp.einsum('bnqkgd,bnskd->bnkgqs', qb, kk).astype(jnp.float32) * (HEAD_DIM ** -0.5)
    logits = logits + rel_bias(d, table)
    logits = jnp.where(mask[None, :, None, None], logits, NEG)
    p = sink_softmax(logits, sinks)
    out = jnp.einsum('bnkgqs,bnskd->bnqkgd', p.astype(v.dtype), vv).reshape(bsz, tp, D_ATTN)
    return out[:, p_front:p_front + t], k[:, -WINDOW:], v[:, -WINDOW:]


def window_attn_sample(q, k, v, k_buf, v_buf, sinks, table):
    bsz, s = q.shape[:2]
    kk = jnp.concatenate([k_buf, k], axis=1)
    vv = jnp.concatenate([v_buf, v], axis=1)
    d = (WINDOW + jnp.arange(s))[:, None] - jnp.arange(WINDOW + s)[None, :]
    mask = (d >= 0) & (d < WINDOW)
    qg = q.reshape(bsz, s, N_KV, GROUP, HEAD_DIM)
    logits = jnp.einsum('bqkgd,bskd->bkgqs', qg, kk).astype(jnp.float32) * (HEAD_DIM ** -0.5)
    logits = logits + rel_bias(d, table)
    logits = jnp.where(mask, logits, NEG)
    p = sink_softmax(logits, sinks)
    out = jnp.einsum('bkgqs,bskd->bqkgd', p.astype(v.dtype), vv).reshape(bsz, s, D_ATTN)
    return out, kk[:, -WINDOW:], vv[:, -WINDOW:]


def decoder_layer(x, rnn_conv_hist, rnn_h0, ffn_hist, attn_fn,
                  norm_mix, w_in, rnn_conv_w, rnn_conv_b, gate_a_w, gate_a_b, gate_x_w, gate_x_b,
                  rnn_lambda, norm_rnn_out, norm_attn_out, w_out,
                  norm_ffn, w_up, w_gate, ffn_conv_w, ffn_conv_b, w_down):
    bsz, t, _ = x.shape
    h = rmsnorm(x, norm_mix)
    z = h @ w_in
    o1 = D_RNN
    o2 = o1 + D_RNN
    o3 = o2 + D_ATTN
    o4 = o3 + N_KV * HEAD_DIM
    xr, gr, q, k, v = z[..., :o1], z[..., o1:o2], z[..., o2:o3], z[..., o3:o4], z[..., o4:]
    xr_hist = jnp.concatenate([rnn_conv_hist, xr], axis=1)
    xc = causal_dwconv(xr_hist, rnn_conv_w, rnn_conv_b)
    y_rnn, h_last = rglru(xc, rnn_h0, gate_a_w, gate_a_b, gate_x_w, gate_x_b, rnn_lambda)
    y_rnn = y_rnn * jax.nn.gelu(gr)
    y_attn, k_state, v_state = attn_fn(q.reshape(bsz, t, N_HEADS, HEAD_DIM),
                                       k.reshape(bsz, t, N_KV, HEAD_DIM),
                                       v.reshape(bsz, t, N_KV, HEAD_DIM))
    mix = jnp.concatenate([rmsnorm(y_rnn, norm_rnn_out), rmsnorm(y_attn, norm_attn_out)], axis=-1)
    x = x + mix @ w_out
    h2 = rmsnorm(x, norm_ffn)
    u = h2 @ w_up
    u_hist = jnp.concatenate([ffn_hist, u], axis=1)
    uc = causal_dwconv(u_hist, ffn_conv_w, ffn_conv_b)
    x = x + (jax.nn.gelu(uc) * (h2 @ w_gate)) @ w_down
    return x, xr_hist[:, -(RNN_CONV - 1):], h_last, k_state, v_state, u_hist[:, -(FFN_CONV - 1):]


def setup_inputs(seed: int = 0) -> dict:
    key = jax.random.key(seed)
    ks = jax.random.split(key, 32)
    f32 = jnp.float32
    nrm = lambda k, shape, s: jax.random.normal(k, shape, f32) * s
    u = jax.random.uniform(ks[10], (DEPTH, D_RNN), f32, 0.9, 0.999)
    s_gate = u ** (1.0 / LRU_C)
    rnn_lambda = jnp.log(s_gate) - jnp.log1p(-s_gate)
    return {
        "x_prompt": nrm(ks[0], (BATCH, SEQ, D_MODEL), 1.0),
        "x_sample": nrm(ks[1], (DEC_BATCH, DEC_SEQ, D_MODEL), 1.0),
        "state_rnn_conv": nrm(ks[2], (DEPTH, DEC_BATCH, RNN_CONV - 1, D_RNN), 1.0),
        "state_rnn_h": nrm(ks[3], (DEPTH, DEC_BATCH, D_RNN), 0.5),
        "cache_k_win": nrm(ks[4], (DEPTH, DEC_BATCH, WINDOW, N_KV, HEAD_DIM), 1.0),
        "cache_v_win": nrm(ks[5], (DEPTH, DEC_BATCH, WINDOW, N_KV, HEAD_DIM), 1.0),
        "state_ffn_conv": nrm(ks[6], (DEPTH, DEC_BATCH, FFN_CONV - 1, D_FF), 1.0),
        "meta_tokens": nrm(ks[7], (N_META, D_MODEL), 1.0),
        "rel_bias_table": nrm(ks[8], (NUM_BUCKETS, N_HEADS), 0.5),
        "norm_mix": 1.0 + nrm(ks[9], (DEPTH, D_MODEL), 0.02),
        "w_in": nrm(ks[11], (DEPTH, D_MODEL, D_IN), D_MODEL ** -0.5),
        "rnn_conv_w": nrm(ks[12], (DEPTH, RNN_CONV, D_RNN), RNN_CONV ** -0.5),
        "rnn_conv_b": nrm(ks[13], (DEPTH, D_RNN), 0.01),
        "gate_a_w": nrm(ks[14], (DEPTH, N_RNN_BLOCKS, RNN_BLOCK, RNN_BLOCK), RNN_BLOCK ** -0.5),
        "gate_a_b": nrm(ks[15], (DEPTH, D_RNN), 0.01),
        "gate_x_w": nrm(ks[16], (DEPTH, N_RNN_BLOCKS, RNN_BLOCK, RNN_BLOCK), RNN_BLOCK ** -0.5),
        "gate_x_b": nrm(ks[17], (DEPTH, D_RNN), 0.01),
        "rnn_lambda": rnn_lambda,
        "attn_sinks": nrm(ks[18], (DEPTH, N_HEADS), 0.5),
        "norm_rnn_out": 1.0 + nrm(ks[19], (DEPTH, D_RNN), 0.02),
        "norm_attn_out": 1.0 + nrm(ks[20], (DEPTH, D_ATTN), 0.02),
        "w_out": nrm(ks[21], (DEPTH, D_MIX, D_MODEL), D_MIX ** -0.5),
        "norm_ffn": 1.0 + nrm(ks[22], (DEPTH, D_MODEL), 0.02),
        "w_up": nrm(ks[23], (DEPTH, D_MODEL, D_FF), D_MODEL ** -0.5),
        "w_gate": nrm(ks[24], (DEPTH, D_MODEL, D_FF), D_MODEL ** -0.5),
        "ffn_conv_w": nrm(ks[25], (DEPTH, FFN_CONV, D_FF), FFN_CONV ** -0.5),
        "ffn_conv_b": nrm(ks[26], (DEPTH, D_FF), 0.01),
        "w_down": nrm(ks[27], (DEPTH, D_FF, D_MODEL), D_FF ** -0.5),
        "norm_final": 1.0 + nrm(ks[28], (D_MODEL,), 0.02),
    }


def reference(x_prompt, x_sample, state_rnn_conv, state_rnn_h, cache_k_win, cache_v_win, state_ffn_conv,
              meta_tokens, rel_bias_table, norm_mix, w_in, rnn_conv_w, rnn_conv_b,
              gate_a_w, gate_a_b, gate_x_w, gate_x_b, rnn_lambda, attn_sinks,
              norm_rnn_out, norm_attn_out, w_out, norm_ffn, w_up, w_gate,
              ffn_conv_w, ffn_conv_b, w_down, norm_final):
    dt = x_prompt.dtype
    meta = jnp.broadcast_to(meta_tokens.astype(dt)[None], (x_prompt.shape[0], N_META, D_MODEL))
    xp = jnp.concatenate([meta, x_prompt], axis=1)
    xs = x_sample
    bp = xp.shape[0]
    p_states = ([], [], [], [], [])
    s_states = ([], [], [], [], [])
    for l in range(DEPTH):
        lw = (norm_mix[l], w_in[l], rnn_conv_w[l], rnn_conv_b[l], gate_a_w[l], gate_a_b[l],
              gate_x_w[l], gate_x_b[l], rnn_lambda[l], norm_rnn_out[l], norm_attn_out[l], w_out[l],
              norm_ffn[l], w_up[l], w_gate[l], ffn_conv_w[l], ffn_conv_b[l], w_down[l])
        attn_p = functools.partial(window_attn_prompt, sinks=attn_sinks[l], table=rel_bias_table)
        xp, *ps = decoder_layer(xp,
                                jnp.zeros((bp, RNN_CONV - 1, D_RNN), dt),
                                jnp.zeros((bp, D_RNN), dt),
                                jnp.zeros((bp, FFN_CONV - 1, D_FF), dt),
                                attn_p, *lw)
        attn_s = functools.partial(window_attn_sample, k_buf=cache_k_win[l], v_buf=cache_v_win[l],
                                   sinks=attn_sinks[l], table=rel_bias_table)
        xs, *ss = decoder_layer(xs, state_rnn_conv[l], state_rnn_h[l], state_ffn_conv[l], attn_s, *lw)
        for lst, val in zip(p_states, ps):
            lst.append(val)
        for lst, val in zip(s_states, ss):
            lst.append(val)
    y_prompt = rmsnorm(xp, norm_final)[:, N_META:]
    y_sample = rmsnorm(xs, norm_final)
    return (y_prompt, y_sample,
            jnp.stack(p_states[0]), jnp.stack(p_states[1]), jnp.stack(p_states[2]),
            jnp.stack(p_states[3]), jnp.stack(p_states[4]),
            jnp.stack(s_states[0]), jnp.stack(s_states[1]), jnp.stack(s_states[2]),
            jnp.stack(s_states[3]), jnp.stack(s_states[4]))
```

```cpp
#include <hip/hip_runtime.h>
#include <hip/hip_cooperative_groups.h>
#include <cstdio>
#include <cstdint>
#include <cstring>

constexpr int D = 2048, NBIG = 8192, NMETA = 16, NSAMP = 128, TP = NBIG + NMETA  ;
constexpr int MROWS = NBIG + NMETA + NSAMP  , MP = 8448  ;
constexpr int DRNN = 1024, DATT = 1024, DIN = 3584, DFF = 6144, HD = 128, NH = 8, NKV = 2, WIN = 128;
constexpr int ZC_XR = 0, ZC_GR = 1024, ZC_Q = 2048, ZC_K = 3072, ZC_V = 3328;
constexpr int ROW_META = NBIG, ROW_SAMP = NBIG + NMETA;
constexpr float EPS = 1e-6f;
__host__ __device__ __forceinline__ int tok2row(int t) { return t >= NMETA ? t - NMETA : ROW_META + t; }

constexpr size_t O_Y = 0, O_YS = 16777216, O_PRC = 17039360, O_PRH = 17042432, O_PK = 17043456, O_PV = 17076224, O_PFC = 17108992,
                 O_SRC = 17121280, O_SRH = 17514496, O_SK = 17645568, O_SV = 21839872, O_SFC = 26034176, O_END = 27607040;

typedef unsigned short bf16_t;
typedef float f32x4 __attribute__((ext_vector_type(4)));
typedef float f32x2 __attribute__((ext_vector_type(2)));
typedef unsigned u32x4 __attribute__((ext_vector_type(4)));
typedef unsigned u32x2 __attribute__((ext_vector_type(2)));

__device__ __forceinline__ float bf2f(bf16_t b) { return __uint_as_float(((unsigned)b) << 16); }
__device__ __forceinline__ unsigned f2bf(float f) { unsigned u = __float_as_uint(f); return (u + 0x7fffu + ((u >> 16) & 1u)) >> 16; }
__device__ __forceinline__ unsigned pk2(float lo, float hi) { return f2bf(lo) | (f2bf(hi) << 16); }
__device__ __forceinline__ float wave_sum(float v) {
#pragma unroll
    for (int o = 1; o < 64; o <<= 1) v += __shfl_xor(v, o);
    return v;
}
__device__ __forceinline__ float wave_max(float v) {
#pragma unroll
    for (int o = 1; o < 64; o <<= 1) v = fmaxf(v, __shfl_xor(v, o));
    return v;
}
__device__ __forceinline__ float gelu_tanh(float x) {
    const float e = __builtin_amdgcn_exp2f(x * (1.0f + 0.044715f * x * x) * (-2.3022081985f));
    return x * __builtin_amdgcn_rcpf(1.0f + e);
}
__device__ __forceinline__ float sigmoid_f(float x) { return __builtin_amdgcn_rcpf(1.0f + __builtin_amdgcn_exp2f(x * (-1.4426950409f))); }

struct RowMap { float* out; float* xs; };
__device__ __forceinline__ float* xrow_ptr(const RowMap& R, int row) {
    if (row < NBIG) return R.out + O_Y + (size_t)row * D;
    if (row < ROW_SAMP) return R.xs + (size_t)(row - ROW_META) * D;
    if (row < MROWS) return R.out + O_YS + (size_t)(row - ROW_SAMP) * D;
    return nullptr;
}
struct XIn { const float* xp; const float* meta; const float* xsamp; };
__device__ __forceinline__ const float* xin_ptr(const XIn& X, int row) {
    if (row < NBIG) return X.xp + (size_t)row * D;
    if (row < ROW_SAMP) return X.meta + (size_t)(row - ROW_META) * D;
    if (row < MROWS) return X.xsamp + (size_t)(row - ROW_SAMP) * D;
    return nullptr;
}
namespace pg8 {
#define PG8_LAS __attribute__((address_space(3)))
typedef unsigned short bf16_t;
typedef short bf16x8 __attribute__((ext_vector_type(8)));
typedef float f32x4 __attribute__((ext_vector_type(4)));
typedef unsigned u32x4 __attribute__((ext_vector_type(4)));
constexpr int BM = 256, BK = 64, HALF = 128, HTB = HALF * BK * 2  , STAGE_BYTES = 8 * HTB, NXCD = 8, WGM = 8;

__host__ __device__ __forceinline__ int lds_byte(int r, int c) { const int st = (r >> 4) * 2 + (c >> 5), rr = r & 15, cc = c & 31, ob = rr * 64 + cc * 2; return st * 1024 + (ob ^ (((ob >> 9) & 1) << 5)); }
__host__ __device__ __forceinline__ void stage_rc(int b, int& R, int& C) { const int st = b / 1024, sb = b % 1024, swz = sb ^ (((sb >> 9) & 1) << 5); R = (st >> 1) * 16 + swz / 64; C = (st & 1) * 32 + (swz % 64) / 2; }
__host__ __device__ __forceinline__ int perm32(int rho) { const int n = rho >> 4, i = rho & 15; return 8 * (i >> 2) + 4 * n + (i & 3); }

struct Unit { int pm, pn; };
struct Gemm { const bf16_t* A; const bf16_t* Bt; int M, N, K; };

struct StaticOrder {
    int nM, nN, nwg, G, c;
    __host__ __device__ void init(int M, int N, int G_, int c_) { nM = M / BM; nN = N / BM; nwg = nM * nN; G = G_; c = c_; }
    __host__ __device__ bool next(int i, Unit& u) const {
        const long L = (long)i * G + c; if (L >= nwg) return false;
        int wgid = (int)L; { const int q = nwg / NXCD, r = nwg % NXCD, xcd = wgid % NXCD, off = wgid / NXCD; wgid = (xcd < r ? xcd * (q + 1) : r * (q + 1) + (xcd - r) * q) + off; }
        const int nig = WGM * nN, gid = wgid / nig, fm = gid * WGM, gsz = (nM - fm) < WGM ? (nM - fm) : WGM;
        u.pm = fm + ((wgid % nig) % gsz); u.pn = (wgid % nig) / gsz; return true;
    }
    __device__ __forceinline__ void a_ready(const Unit&) const {}
    __device__ __forceinline__ void done(const Unit&) const {}
};

__device__ __forceinline__ unsigned cvt_pk_bf16(float lo, float hi) { unsigned r; asm volatile("v_cvt_pk_bf16_f32 %0, %1, %2" : "=v"(r) : "v"(lo), "v"(hi)); return r; }

struct EpiZ {
    static constexpr bool PERM = true, AFTER_DRAIN = false;
    bf16_t* O; int ldc;
    __device__ __forceinline__ void operator()(const f32x4 (&acc)[2][2][4][2], const Unit& u, int wr, int wc, int fr, int fq) const {
        const int row0 = u.pm * BM + wr * 64 + fr, col0 = u.pn * BM + wc * 32 + 8 * fq;
#pragma unroll
        for (int ai = 0; ai < 2; ++ai)
#pragma unroll
            for (int m = 0; m < 4; ++m) { bf16_t* rowp = O + (size_t)(row0 + ai * HALF + m * 16) * ldc + col0;
#pragma unroll
                for (int bj = 0; bj < 2; ++bj) { const f32x4 v0 = acc[ai][bj][m][0], v1 = acc[ai][bj][m][1];
                    u32x4 w; w.x = cvt_pk_bf16(v0[0], v0[1]); w.y = cvt_pk_bf16(v0[2], v0[3]); w.z = cvt_pk_bf16(v1[0], v1[1]); w.w = cvt_pk_bf16(v1[2], v1[3]);
                    *(u32x4*)(rowp + bj * HALF) = w; } }
    }
};

struct EpiRes {
    static constexpr bool PERM = false, AFTER_DRAIN = false;
    RowMap R; XIn X; int mode; int pad_;
    __device__ __forceinline__ void operator()(const f32x4 (&acc)[2][2][4][2], const Unit& u, int wr, int wc, int fr, int fq) const {
        const int col0 = u.pn * BM + wc * 32 + 4 * fq;
#pragma unroll
        for (int ai = 0; ai < 2; ++ai)
#pragma unroll
            for (int m = 0; m < 4; ++m) {
                const int row = u.pm * BM + ai * HALF + wr * 64 + m * 16 + fr;
                float* d = xrow_ptr(R, row);
                if (d) {
                    const float* b = mode == 0 ? xin_ptr(X, row) : d;
#pragma unroll
                    for (int bj = 0; bj < 2; ++bj)
#pragma unroll
                        for (int n = 0; n < 2; ++n) { const int off = col0 + bj * HALF + n * 16; *(f32x4*)(d + off) = *(const f32x4*)(b + off) + acc[ai][bj][m][n]; }
                }
            }
    }
};

struct EpiUG {
    static constexpr bool PERM = true, AFTER_DRAIN = false;
    bf16_t* ACT; const float* rs1; const float* cw; const float* cb; const float* st; float* halo; float* first; float* out_sfc;
    __device__ __forceinline__ void operator()(const f32x4 (&acc)[2][2][4][2], const Unit& u, int wr, int wc, int fr, int fq) const {
        const int lane = (fq << 4) | fr;
        const int ch0 = u.pn * 128 + wc * 32 + 8 * fq;
        float w0[8], w1[8], w2[8], b0[8];
#pragma unroll
        for (int h = 0; h < 2; ++h) {
            const f32x4 a = *(const f32x4*)(cw + ch0 + 4 * h), b = *(const f32x4*)(cw + DFF + ch0 + 4 * h), c = *(const f32x4*)(cw + 2 * DFF + ch0 + 4 * h), d = *(const f32x4*)(cb + ch0 + 4 * h);
#pragma unroll
            for (int j = 0; j < 4; ++j) { w0[4 * h + j] = a[j]; w1[4 * h + j] = b[j]; w2[4 * h + j] = c[j]; b0[4 * h + j] = d[j]; }
        }
        const int src1 = (lane & 48) | ((fr + 15) & 15), src2 = (lane & 48) | ((fr + 14) & 15);
#pragma unroll
        for (int ai = 0; ai < 2; ++ai) {
            float pu[8];
#pragma unroll
            for (int e = 0; e < 8; ++e) pu[e] = 0.f;
#pragma unroll
            for (int m = 0; m < 4; ++m) {
                const int R0 = u.pm * BM + ai * HALF + wr * 64 + m * 16, row = R0 + fr;
                if (R0 >= MROWS) continue;
                const float rs = rs1[row];
                float uu[8], gg[8];
#pragma unroll
                for (int n = 0; n < 2; ++n)
#pragma unroll
                    for (int j = 0; j < 4; ++j) { uu[4 * n + j] = acc[ai][0][m][n][j] * rs; gg[4 * n + j] = acc[ai][1][m][n][j] * rs; }
                if (R0 < NBIG) {
                    float act[8];
#pragma unroll
                    for (int e = 0; e < 8; ++e) {
                        const float c1 = __shfl(uu[e], src1), c2 = __shfl(uu[e], src2), p1 = __shfl(pu[e], src1), p2 = __shfl(pu[e], src2);
                        const float um1 = fr >= 1 ? c1 : p1, um2 = fr >= 2 ? c2 : p2;
                        act[e] = gelu_tanh(b0[e] + w0[e] * um2 + w1[e] * um1 + w2[e] * uu[e]) * gg[e];
                    }
                    const int q = R0 >> 6;
                    if (m == 0 && fr < 2) {
                        float* f = first + ((size_t)(q * 2 + fr) * 2) * DFF + ch0;
                        *(f32x4*)(f) = (f32x4){uu[0], uu[1], uu[2], uu[3]}; *(f32x4*)(f + 4) = (f32x4){uu[4], uu[5], uu[6], uu[7]};
                        *(f32x4*)(f + DFF) = (f32x4){gg[0], gg[1], gg[2], gg[3]}; *(f32x4*)(f + DFF + 4) = (f32x4){gg[4], gg[5], gg[6], gg[7]};
                    } else {
                        u32x4 w; w.x = cvt_pk_bf16(act[0], act[1]); w.y = cvt_pk_bf16(act[2], act[3]); w.z = cvt_pk_bf16(act[4], act[5]); w.w = cvt_pk_bf16(act[6], act[7]);
                        *(u32x4*)(ACT + (size_t)row * DFF + ch0) = w;
                    }
                    if (m == 3 && fr >= 14) {
                        float* f = halo + ((size_t)q * 2 + (fr - 14)) * DFF + ch0;
                        *(f32x4*)(f) = (f32x4){uu[0], uu[1], uu[2], uu[3]}; *(f32x4*)(f + 4) = (f32x4){uu[4], uu[5], uu[6], uu[7]};
                    }
#pragma unroll
                    for (int e = 0; e < 8; ++e) pu[e] = uu[e];
                } else if (R0 == ROW_META) {
                    if (fr >= 14) {
                        float* f = halo + ((size_t)128 * 2 + (fr - 14)) * DFF + ch0;
                        *(f32x4*)(f) = (f32x4){uu[0], uu[1], uu[2], uu[3]}; *(f32x4*)(f + 4) = (f32x4){uu[4], uu[5], uu[6], uu[7]};
                    }
                } else {
                    const int b = row - ROW_SAMP;
                    const float* s0p = st + ((size_t)b * 2) * DFF + ch0; const float* s1p = s0p + DFF;
                    const f32x4 s0a = *(const f32x4*)s0p, s0b = *(const f32x4*)(s0p + 4), s1a = *(const f32x4*)s1p, s1b = *(const f32x4*)(s1p + 4);
                    float act[8];
#pragma unroll
                    for (int e = 0; e < 8; ++e) {
                        const float h0 = e < 4 ? s0a[e & 3] : s0b[e & 3], h1 = e < 4 ? s1a[e & 3] : s1b[e & 3];
                        act[e] = gelu_tanh(b0[e] + w0[e] * h0 + w1[e] * h1 + w2[e] * uu[e]) * gg[e];
                    }
                    u32x4 w; w.x = cvt_pk_bf16(act[0], act[1]); w.y = cvt_pk_bf16(act[2], act[3]); w.z = cvt_pk_bf16(act[4], act[5]); w.w = cvt_pk_bf16(act[6], act[7]);
                    *(u32x4*)(ACT + (size_t)row * DFF + ch0) = w;
                    float* o = out_sfc + ((size_t)b * 2) * DFF + ch0;
                    *(f32x4*)(o) = s1a; *(f32x4*)(o + 4) = s1b;
                    *(f32x4*)(o + DFF) = (f32x4){uu[0], uu[1], uu[2], uu[3]}; *(f32x4*)(o + DFF + 4) = (f32x4){uu[4], uu[5], uu[6], uu[7]};
                }
            }
        }
    }
};

template <class Epi, class Sched, bool ALIGN_EPI = false, bool SP2 = false>
__device__ __forceinline__ void gemm_phase(PG8_LAS unsigned char* lds, const Gemm g, const Sched& S, const Epi& E) {
    const int tid = threadIdx.x, wid = __builtin_amdgcn_readfirstlane(tid >> 6), lane = tid & 63, wr = wid >> 2, wc = wid & 3, fr = lane & 15, fq = lane >> 4;
    const int K = g.K, nt = K / BK;
    unsigned voffA[2], voffB[2];
#pragma unroll
    for (int i = 0; i < 2; ++i) { int R, C; stage_rc(tid * 16 + i * 8192, R, C); const int Rb = Epi::PERM ? ((R & ~31) + perm32(R & 31)) : R;
        voffA[i] = (unsigned)(R * K + C) * 2u; voffB[i] = (unsigned)(Rb * K + C) * 2u; }
    const size_t kstep = (size_t)(BK * 2);
    const size_t hstep = (size_t)HALF * K * 2;
    const size_t tstep = 2 * hstep;
    const unsigned ldsw = (unsigned)wid * 1024u;
    const int aoff = lds_byte(wr * 64 + fr, fq * 8), boff = lds_byte(wc * 32 + fr, fq * 8);
#define PG8_SA(b, h) (((b) * 2 + (h)) * HTB)
#define PG8_SB(b, h) ((4 + (b) * 2 + (h)) * HTB)
#define PG8_STAGE(bufoff, gbase, voff) do { _Pragma("unroll") for (int _i = 0; _i < 2; ++_i) \
        __builtin_amdgcn_global_load_lds((const unsigned*)((const char*)(gbase) + (voff)[_i]), (PG8_LAS unsigned*)(lds + (bufoff) + ldsw + _i * 8192), 16, 0, 0); } while (0)
#define PG8_LDA(dst, b, h) do { _Pragma("unroll") for (int m = 0; m < 4; ++m) _Pragma("unroll") for (int k = 0; k < 2; ++k) dst[m][k] = *(const PG8_LAS bf16x8*)(lds + PG8_SA(b, h) + aoff + m * 2048 + k * 1024); } while (0)
#define PG8_LDB(dst, b, h) do { _Pragma("unroll") for (int n = 0; n < 2; ++n) _Pragma("unroll") for (int k = 0; k < 2; ++k) dst[n][k] = *(const PG8_LAS bf16x8*)(lds + PG8_SB(b, h) + boff + n * 2048 + k * 1024); } while (0)
#define PG8_MMA(ai, bj, At, Bt) do { __builtin_amdgcn_s_setprio(1); _Pragma("unroll") for (int m = 0; m < 4; ++m) _Pragma("unroll") for (int n = 0; n < 2; ++n) _Pragma("unroll") for (int k = 0; k < 2; ++k) \
        acc[ai][bj][m][n] = __builtin_amdgcn_mfma_f32_16x16x32_bf16(Bt[n][k], At[m][k], acc[ai][bj][m][n], 0, 0, 0); __builtin_amdgcn_s_setprio(0); } while (0)
#define PG8_WAIT_V(n) asm volatile("s_waitcnt vmcnt(" #n ")" ::: "memory")
#define PG8_WAIT_L(n) asm volatile("s_waitcnt lgkmcnt(" #n ")" ::: "memory")
#define PG8_BAR __builtin_amdgcn_s_barrier()
#define PG8_SCHED __builtin_amdgcn_sched_barrier(0)
    Unit cur, nxt; int ui = 0;
    if (!S.next(0, cur)) return;
    f32x4 acc[2][2][4][2];
#pragma unroll
    for (int a = 0; a < 2; ++a)
#pragma unroll
        for (int b = 0; b < 2; ++b)
#pragma unroll
            for (int m = 0; m < 4; ++m)
#pragma unroll
                for (int n = 0; n < 2; ++n) acc[a][b][m][n] = (f32x4){0.f, 0.f, 0.f, 0.f};
    bf16x8 At[4][2], B0[2][2], B1[2][2];
    const char* cA = (const char*)g.A + (size_t)cur.pm * tstep; const char* cB = (const char*)g.Bt + (size_t)cur.pn * tstep;
    S.a_ready(cur);
    if constexpr (SP2) {
        PG8_STAGE(PG8_SB(0, 0), cB, voffB); PG8_STAGE(PG8_SB(0, 1), cB + hstep, voffB); PG8_STAGE(PG8_SA(0, 0), cA, voffA); PG8_STAGE(PG8_SA(0, 1), cA + hstep, voffA);
        if (wr == 1) PG8_BAR;
        PG8_WAIT_V(2); PG8_BAR;
        PG8_STAGE(PG8_SB(1, 0), cB + kstep, voffB); PG8_STAGE(PG8_SA(1, 0), cA + kstep, voffA); PG8_STAGE(PG8_SB(1, 1), cB + hstep + kstep, voffB);
        PG8_WAIT_V(6); PG8_BAR;
    } else {
        PG8_STAGE(PG8_SB(0, 0), cB, voffB); PG8_STAGE(PG8_SA(0, 0), cA, voffA); PG8_STAGE(PG8_SB(0, 1), cB + hstep, voffB); PG8_STAGE(PG8_SA(0, 1), cA + hstep, voffA);
        if (wr == 1) PG8_BAR;
        PG8_WAIT_V(4); PG8_BAR;
        PG8_STAGE(PG8_SB(1, 0), cB + kstep, voffB); PG8_STAGE(PG8_SA(1, 0), cA + kstep, voffA); PG8_STAGE(PG8_SB(1, 1), cB + hstep + kstep, voffB);
        PG8_WAIT_V(6); PG8_BAR;
    }
    for (;;) {
        const bool has_next = S.next(ui + 1, nxt);
        const char* nA = has_next ? (const char*)g.A + (size_t)nxt.pm * tstep : cA; const char* nB = has_next ? (const char*)g.Bt + (size_t)nxt.pn * tstep : cB;
        for (int t = 0; t < nt; t += 2) {
            const bool last = (t == nt - 2);
            const char* a1 = cA + (size_t)(t + 1) * kstep;
            const char* a2 = last ? nA : cA + (size_t)(t + 2) * kstep; const char* b2 = last ? nB : cB + (size_t)(t + 2) * kstep;
            const char* a3 = a2 + kstep; const char* b3 = b2 + kstep;
            if (last && has_next) S.a_ready(nxt);
            if constexpr (SP2) {
            PG8_LDB(B0, 0, 0); PG8_LDB(B1, 0, 1); PG8_SCHED; PG8_LDA(At, 0, 0); PG8_STAGE(PG8_SA(1, 1), a1 + hstep, voffA);
            PG8_WAIT_V(8); PG8_WAIT_L(0); PG8_BAR; PG8_MMA(0, 0, At, B0); PG8_MMA(0, 1, At, B1); PG8_BAR; PG8_SCHED;
            PG8_LDA(At, 0, 1); PG8_STAGE(PG8_SB(0, 0), b2, voffB); PG8_STAGE(PG8_SB(0, 1), b2 + hstep, voffB); PG8_STAGE(PG8_SA(0, 0), a2, voffA);
            PG8_WAIT_V(8); PG8_WAIT_L(0); PG8_BAR; PG8_MMA(1, 0, At, B0); PG8_MMA(1, 1, At, B1); PG8_BAR; PG8_SCHED;
            PG8_LDB(B0, 1, 0); PG8_LDB(B1, 1, 1); PG8_SCHED; PG8_LDA(At, 1, 0); PG8_STAGE(PG8_SA(0, 1), a2 + hstep, voffA);
            PG8_WAIT_V(8); PG8_WAIT_L(0); PG8_BAR; PG8_MMA(0, 0, At, B0); PG8_MMA(0, 1, At, B1); PG8_BAR; PG8_SCHED;
            PG8_LDA(At, 1, 1); PG8_STAGE(PG8_SB(1, 0), b3, voffB); PG8_STAGE(PG8_SB(1, 1), b3 + hstep, voffB); PG8_STAGE(PG8_SA(1, 0), a3, voffA);
            PG8_WAIT_V(8); PG8_WAIT_L(0); PG8_BAR; PG8_MMA(1, 0, At, B0); PG8_MMA(1, 1, At, B1); PG8_BAR; PG8_SCHED;
            } else {
            PG8_LDB(B0, 0, 0); PG8_SCHED; PG8_LDA(At, 0, 0); PG8_STAGE(PG8_SA(1, 1), a1 + hstep, voffA);
            PG8_WAIT_L(8); PG8_BAR; PG8_WAIT_L(0); PG8_MMA(0, 0, At, B0); PG8_BAR; PG8_SCHED;
            PG8_LDB(B1, 0, 1); PG8_STAGE(PG8_SB(0, 0), b2, voffB);
            PG8_BAR; PG8_WAIT_L(0); PG8_MMA(0, 1, At, B1); PG8_BAR;
            PG8_LDA(At, 0, 1); PG8_STAGE(PG8_SA(0, 0), a2, voffA);
            PG8_BAR; PG8_WAIT_L(0); PG8_MMA(1, 0, At, B0); PG8_BAR; PG8_SCHED;
            PG8_STAGE(PG8_SB(0, 1), b2 + hstep, voffB);
            PG8_WAIT_V(6); PG8_BAR; PG8_MMA(1, 1, At, B1); PG8_BAR;
            PG8_LDB(B0, 1, 0); PG8_SCHED; PG8_LDA(At, 1, 0); PG8_STAGE(PG8_SA(0, 1), a2 + hstep, voffA);
            PG8_WAIT_L(8); PG8_BAR; PG8_WAIT_L(0); PG8_MMA(0, 0, At, B0); PG8_BAR; PG8_SCHED;
            PG8_LDB(B1, 1, 1); PG8_STAGE(PG8_SB(1, 0), b3, voffB);
            PG8_BAR; PG8_WAIT_L(0); PG8_MMA(0, 1, At, B1); PG8_BAR;
            PG8_LDA(At, 1, 1); PG8_STAGE(PG8_SA(1, 0), a3, voffA);
            PG8_BAR; PG8_WAIT_L(0); PG8_MMA(1, 0, At, B0); PG8_BAR; PG8_SCHED;
            PG8_STAGE(PG8_SB(1, 1), b3 + hstep, voffB);
            PG8_WAIT_V(6); PG8_BAR; PG8_MMA(1, 1, At, B1); PG8_BAR;
            }
        }
        if constexpr (ALIGN_EPI) { if (wr == 0) PG8_BAR; }
        if constexpr (!Epi::AFTER_DRAIN) { E(acc, cur, wr, wc, fr, fq); S.done(cur); }
        if (!has_next) break;
#pragma unroll
        for (int a = 0; a < 2; ++a)
#pragma unroll
            for (int b = 0; b < 2; ++b)
#pragma unroll
                for (int m = 0; m < 4; ++m)
#pragma unroll
                    for (int n = 0; n < 2; ++n) acc[a][b][m][n] = (f32x4){0.f, 0.f, 0.f, 0.f};
        cur = nxt; cA = nA; cB = nB; ++ui;
        if constexpr (ALIGN_EPI) { if (wr == 1) PG8_BAR; }
    }
    PG8_WAIT_V(0);
    if constexpr (!ALIGN_EPI) { if (wr == 0) PG8_BAR; }
    PG8_BAR;
    if constexpr (Epi::AFTER_DRAIN) { E.fused(acc, cur, wr, wc, fr, fq, lds, wid, lane); S.done(cur); }
#undef PG8_SA
#undef PG8_SB
#undef PG8_STAGE
#undef PG8_LDA
#undef PG8_LDB
#undef PG8_MMA
#undef PG8_WAIT_V
#undef PG8_WAIT_L
#undef PG8_BAR
#undef PG8_SCHED
}
}

using pg8::Gemm;
#define LAS __attribute__((address_space(3)))

constexpr size_t MiB = 1u << 20;
constexpr size_t WS_CTL = 0;
constexpr size_t WS_WIN = 1 * MiB;
constexpr size_t WS_WOUT = WS_WIN + (size_t)DIN * D * 2;
constexpr size_t WS_WUG = WS_WOUT + (size_t)D * D * 2;
constexpr size_t WS_WDN = WS_WUG + (size_t)2 * DFF * D * 2;
constexpr size_t WS_R1 = WS_WDN + (size_t)D * DFF * 2;
constexpr size_t WS_H0 = WS_R1;
constexpr size_t WS_Z = WS_H0 + (size_t)MP * D * 2;
constexpr size_t WS_MIX = WS_Z + (size_t)MP * DIN * 2;
constexpr size_t WS_ACT = WS_R1;
constexpr size_t WS_R1_END = WS_MIX + (size_t)MP * D * 2;
constexpr size_t WS_X1B = WS_R1_END;
constexpr size_t WS_XS = WS_X1B + (size_t)MP * D * 2;
constexpr size_t WS_RS1 = WS_XS + (size_t)64 * D * 4;
constexpr size_t WS_HALO = WS_RS1 + (size_t)MP * 4;
constexpr size_t WS_FIRST = WS_HALO + (size_t)129 * 2 * DFF * 4;
constexpr size_t WS_END = WS_FIRST + (size_t)128 * 4 * DFF * 4;
static_assert(WS_ACT + (size_t)MP * DFF * 2 <= WS_R1_END, "ACT overlay fits in H0|Z|MIX");
static_assert(WS_END <= 308053024, "workspace map must fit the guaranteed d_ws size");

__global__ void __launch_bounds__(512) k_prep_rows(XIn X, bf16_t* H0) {
    const int row = blockIdx.x * 8 + (threadIdx.x >> 6), lane = threadIdx.x & 63;
    if (row >= MP) return;
    u32x2* o = (u32x2*)(H0 + (size_t)row * D) + lane;
    const float* src = xin_ptr(X, row);
    if (!src) {
#pragma unroll
        for (int j = 0; j < 8; ++j) o[64 * j] = (u32x2){0u, 0u};
        return;
    }
    const f32x4* xr = (const f32x4*)src + lane;
    f32x4 v[8]; float s = 0.f;
#pragma unroll
    for (int j = 0; j < 8; ++j) { v[j] = xr[64 * j]; s += (v[j].x * v[j].x + v[j].y * v[j].y) + (v[j].z * v[j].z + v[j].w * v[j].w); }
    const float rs = 1.0f / sqrtf(wave_sum(s) * (1.0f / D) + EPS);
#pragma unroll
    for (int j = 0; j < 8; ++j) o[64 * j] = (u32x2){pk2(v[j].x * rs, v[j].y * rs), pk2(v[j].z * rs, v[j].w * rs)};
}

struct WPrep { const float *w_in, *w_out, *w_up, *w_gate, *w_down, *g_mix, *g_rnn, *g_attn, *g_ffn; bf16_t *t_in, *t_out, *t_ug, *t_dn; };
constexpr int WT_IN = (D / 64) * (DIN / 64), WT_OUT = (D / 64) * (D / 64), WT_UP = (D / 64) * (DFF / 64), WT_DN = (DFF / 64) * (D / 64);
constexpr int WT_TOTAL = WT_IN + WT_OUT + 2 * WT_UP + WT_DN;
__device__ __forceinline__ void wprep_tile(const WPrep& P, int it, float* s  , int tid) {
    const float* W; bf16_t* Wt; int K, N, job;
    if (it < WT_IN) { job = 0; W = P.w_in; Wt = P.t_in; K = D; N = DIN; }
    else if ((it -= WT_IN) < WT_OUT) { job = 1; W = P.w_out; Wt = P.t_out; K = D; N = D; }
    else if ((it -= WT_OUT) < WT_UP) { job = 2; W = P.w_up; Wt = P.t_ug; K = D; N = DFF; }
    else if ((it -= WT_UP) < WT_UP) { job = 3; W = P.w_gate; Wt = P.t_ug; K = D; N = DFF; }
    else { it -= WT_UP; job = 4; W = P.w_down; Wt = P.t_dn; K = DFF; N = D; }
    const int nblk = N / 64, kb = it / nblk, nb = it % nblk, k0 = kb * 64, n0 = nb * 64;
    {
        const int nn = tid & 63, kq = tid >> 6;
#pragma unroll 4
        for (int i = 0; i < 16; ++i) {
            const int kk = kq + 4 * i, k = k0 + kk;
            float g = 1.0f;
            if (job == 0) g = P.g_mix[k]; else if (job == 1) g = k < DRNN ? P.g_rnn[k] : P.g_attn[k - DRNN]; else if (job == 2 || job == 3) g = P.g_ffn[k];
            s[kk * 65 + nn] = W[(size_t)k * N + n0 + nn] * g;
        }
    }
    __syncthreads();
#pragma unroll
    for (int h = 0; h < 2; ++h) {
        const int n = tid >> 2, c = (tid & 3) + 4 * h, ng = n0 + n;
        int drow = ng;
        if (job == 2) drow = 256 * (ng >> 7) + (ng & 127); else if (job == 3) drow = 256 * (ng >> 7) + 128 + (ng & 127);
        const float* sp = s + (8 * c) * 65 + n;
        u32x4 o; o.x = pk2(sp[0], sp[65]); o.y = pk2(sp[2 * 65], sp[3 * 65]); o.z = pk2(sp[4 * 65], sp[5 * 65]); o.w = pk2(sp[6 * 65], sp[7 * 65]);
        *(u32x4*)(Wt + (size_t)drow * K + k0 + 8 * c) = o;
    }
    __syncthreads();
}
__global__ void __launch_bounds__(256) k_prep_weights(WPrep P) {
    __shared__ float s[64 * 65];
    for (int it = blockIdx.x; it < WT_TOTAL; it += gridDim.x) wprep_tile(P, it, s, threadIdx.x);
}

struct MixIn {
    const bf16_t* Z; RowMap R;
    const float *st_conv, *st_h, *cache_k, *cache_v;
    const float *conv_w, *conv_b, *ga_w, *ga_b, *gx_w, *gx_b, *lam, *sinks, *table;
    float* out;
};
__global__ void __launch_bounds__(64) k_rglru_seq(MixIn M) {
    __shared__ float s_xc[64];
    const int tid = threadIdx.x; int blk, sb = -1, T;
    if (blockIdx.x < 16) { blk = blockIdx.x; T = TP; } else { sb = (blockIdx.x - 16) >> 4; blk = (blockIdx.x - 16) & 15; T = 1; }
    const int c = blk * 64 + tid;
    float wa[64], wx[64];
#pragma unroll
    for (int k = 0; k < 64; ++k) { wa[k] = M.ga_w[(size_t)(blk * 64 + k) * 64 + tid]; wx[k] = M.gx_w[(size_t)(blk * 64 + k) * 64 + tid]; }
    const float cw0 = M.conv_w[c], cw1 = M.conv_w[DRNN + c], cw2 = M.conv_w[2 * DRNN + c], cw3 = M.conv_w[3 * DRNN + c], cbias = M.conv_b[c];
    const float ba = M.ga_b[c], bx = M.gx_b[c];
    const float lam = M.lam[c];
    const float csp = 8.0f * (fmaxf(-lam, 0.f) + log1pf(expf(-fabsf(lam))));
    float x3 = 0.f, x2 = 0.f, x1 = 0.f, h = 0.f;
    if (sb >= 0) { x3 = M.st_conv[((size_t)sb * 3 + 0) * DRNN + c]; x2 = M.st_conv[((size_t)sb * 3 + 1) * DRNN + c]; x1 = M.st_conv[((size_t)sb * 3 + 2) * DRNN + c]; h = M.st_h[(size_t)sb * DRNN + c]; }
    auto step = [&](float xr, float gr, int row) {
        const float xc = cbias + cw0 * x3 + cw1 * x2 + cw2 * x1 + cw3 * xr;
        x3 = x2; x2 = x1; x1 = xr;
        s_xc[tid] = xc;
        __syncthreads();
        float pa = ba, px = bx;
#pragma unroll
        for (int k = 0; k < 64; ++k) { const float v = s_xc[k]; pa += v * wa[k]; px += v * wx[k]; }
        __syncthreads();
        const float r = 1.0f / (1.0f + expf(-pa)), ig = 1.0f / (1.0f + expf(-px));
        const float la = -csp * r, a = expf(la), b = sqrtf(-expm1f(2.0f * la)) * ig * xc;
        h = a * h + b;
        xrow_ptr(M.R, row)[c] = h * gelu_tanh(gr);
    };
    if (sb >= 0) {
        const int row = ROW_SAMP + sb;
        step(bf2f(M.Z[(size_t)row * DIN + ZC_XR + c]), bf2f(M.Z[(size_t)row * DIN + ZC_GR + c]), row);
        M.out[O_SRH + (size_t)sb * DRNN + c] = h;
        M.out[O_SRC + ((size_t)sb * 3 + 0) * DRNN + c] = x3; M.out[O_SRC + ((size_t)sb * 3 + 1) * DRNN + c] = x2; M.out[O_SRC + ((size_t)sb * 3 + 2) * DRNN + c] = x1;
    } else {
        float nx[8], ng[8], cx[8], cg[8];
#pragma unroll
        for (int u = 0; u < 8; ++u) { const int row = tok2row(u); nx[u] = bf2f(M.Z[(size_t)row * DIN + ZC_XR + c]); ng[u] = bf2f(M.Z[(size_t)row * DIN + ZC_GR + c]); }
        for (int t0 = 0; t0 < T; t0 += 8) {
#pragma unroll
            for (int u = 0; u < 8; ++u) { cx[u] = nx[u]; cg[u] = ng[u]; }
            if (t0 + 8 < T) {
#pragma unroll
                for (int u = 0; u < 8; ++u) { const int row = tok2row(t0 + 8 + u); nx[u] = bf2f(M.Z[(size_t)row * DIN + ZC_XR + c]); ng[u] = bf2f(M.Z[(size_t)row * DIN + ZC_GR + c]); }
            }
#pragma unroll
            for (int u = 0; u < 8; ++u) step(cx[u], cg[u], tok2row(t0 + u));
        }
        M.out[O_PRH + c] = h;
    }
}

__device__ __forceinline__ int rel_bucket(int d) {
    if (d < 16) return d;
    const int l = 16 + (int)(logf((float)d * (1.0f / 16.0f)) / 2.0794415417f * 16.0f);
    return l < 31 ? l : 31;
}
__global__ void __launch_bounds__(256) k_attn_naive(MixIn M) {
    __shared__ float sq[4][128], sp[4][128];
    const int qi = blockIdx.x >> 1, kvh = blockIdx.x & 1, w = threadIdx.x >> 6, lane = threadIdx.x & 63, h = kvh * 4 + w;
    const bool samp = qi >= TP; const int t = qi, sbatch = qi - TP;
    const int qrow = samp ? ROW_SAMP + sbatch : tok2row(t);
    const bf16_t* qp = M.Z + (size_t)qrow * DIN + ZC_Q + h * HD;
    sq[w][lane] = bf2f(qp[lane]) * 0.08838834764831845f; sq[w][lane + 64] = bf2f(qp[lane + 64]) * 0.08838834764831845f;
    __syncthreads();
    const float sink = M.sinks[h];
    float lg[2];
#pragma unroll
    for (int kk = 0; kk < 2; ++kk) {
        const int wi = lane + 64 * kk, dist = 127 - wi;
        float dot = 0.f; bool valid = true;
        if (!samp || wi == 127) {
            const int j = samp ? 0 : t - 127 + wi;
            valid = samp || j >= 0;
            if (valid) {
                const int krow = samp ? qrow : tok2row(j);
                const bf16_t* kp = M.Z + (size_t)krow * DIN + ZC_K + kvh * HD;
                for (int d = 0; d < HD; ++d) dot += sq[w][d] * bf2f(kp[d]);
            }
        } else {
            const float* kp = M.cache_k + (((size_t)sbatch * WIN + wi + 1) * NKV + kvh) * HD;
            for (int d = 0; d < HD; ++d) dot += sq[w][d] * kp[d];
        }
        lg[kk] = valid ? dot + M.table[rel_bucket(dist) * NH + h] : -1e30f;
    }
    const float mx = fmaxf(wave_max(fmaxf(lg[0], lg[1])), sink);
    const float e0 = expf(lg[0] - mx), e1 = expf(lg[1] - mx);
    const float den = wave_sum(e0 + e1) + expf(sink - mx);
    sp[w][lane] = e0 / den; sp[w][lane + 64] = e1 / den;
    __syncthreads();
    float o0 = 0.f, o1 = 0.f;
    for (int wi = 0; wi < WIN; ++wi) {
        const float p = sp[w][wi];
        if (p == 0.f) continue;
        if (!samp || wi == 127) {
            const int j = samp ? 0 : t - 127 + wi;
            const int vrow = samp ? qrow : tok2row(j);
            const bf16_t* vp = M.Z + (size_t)vrow * DIN + ZC_V + kvh * HD;
            o0 += p * bf2f(vp[2 * lane]); o1 += p * bf2f(vp[2 * lane + 1]);
        } else {
            const float* vp = M.cache_v + (((size_t)sbatch * WIN + wi + 1) * NKV + kvh) * HD;
            o0 += p * vp[2 * lane]; o1 += p * vp[2 * lane + 1];
        }
    }
    float* y = xrow_ptr(M.R, qrow) + DRNN + h * HD + 2 * lane;
    y[0] = o0; y[1] = o1;
}
__global__ void __launch_bounds__(256) k_states(MixIn M) {
    const size_t i = (size_t)blockIdx.x * 256 + threadIdx.x;
    const size_t NSK = (size_t)NSAMP * WIN * NKV * HD;
    if (i < NSK) {
        const int d = i & 127, kvh = (i >> 7) & 1, wi = (i >> 8) & 127, b = (int)(i >> 15);
        float k, v;
        if (wi < 127) { const size_t s = (((size_t)b * WIN + wi + 1) * NKV + kvh) * HD + d; k = M.cache_k[s]; v = M.cache_v[s]; }
        else { const bf16_t* z = M.Z + (size_t)(ROW_SAMP + b) * DIN + kvh * HD + d; k = bf2f(z[ZC_K]); v = bf2f(z[ZC_V]); }
        M.out[O_SK + i] = k; M.out[O_SV + i] = v;
    } else if (i < NSK + 32768) {
        const size_t e = i - NSK; const int d = e & 127, kvh = (e >> 7) & 1, wi = (int)(e >> 8);
        const bf16_t* z = M.Z + (size_t)tok2row(TP - WIN + wi) * DIN + kvh * HD + d;
        M.out[O_PK + e] = bf2f(z[ZC_K]); M.out[O_PV + e] = bf2f(z[ZC_V]);
    } else if (i < NSK + 32768 + 3072) {
        const size_t e = i - NSK - 32768; const int c = e & 1023, j = (int)(e >> 10);
        M.out[O_PRC + e] = bf2f(M.Z[(size_t)tok2row(TP - 3 + j) * DIN + ZC_XR + c]);
    }
}
__global__ void __launch_bounds__(512) k_mixnorm(RowMap R, bf16_t* MIX) {
    const int row = blockIdx.x * 8 + (threadIdx.x >> 6), lane = threadIdx.x & 63;
    if (row >= MROWS) return;
    const f32x4* y = (const f32x4*)xrow_ptr(R, row) + lane;
    f32x4 v[8]; float s0 = 0.f, s1 = 0.f;
#pragma unroll
    for (int j = 0; j < 8; ++j) { v[j] = y[64 * j]; const float q = (v[j].x * v[j].x + v[j].y * v[j].y) + (v[j].z * v[j].z + v[j].w * v[j].w); if (j < 4) s0 += q; else s1 += q; }
    const float r0 = 1.0f / sqrtf(wave_sum(s0) * (1.0f / DRNN) + EPS), r1 = 1.0f / sqrtf(wave_sum(s1) * (1.0f / DATT) + EPS);
    u32x2* o = (u32x2*)(MIX + (size_t)row * D) + lane;
#pragma unroll
    for (int j = 0; j < 8; ++j) { const float r = j < 4 ? r0 : r1; o[64 * j] = (u32x2){pk2(v[j].x * r, v[j].y * r), pk2(v[j].z * r, v[j].w * r)}; }
}
__global__ void __launch_bounds__(512) k_x1b(RowMap R, bf16_t* X1b, float* rs1) {
    const int row = blockIdx.x * 8 + (threadIdx.x >> 6), lane = threadIdx.x & 63;
    if (row >= MROWS) return;
    const f32x4* y = (const f32x4*)xrow_ptr(R, row) + lane;
    f32x4 v[8]; float s = 0.f;
#pragma unroll
    for (int j = 0; j < 8; ++j) { v[j] = y[64 * j]; s += (v[j].x * v[j].x + v[j].y * v[j].y) + (v[j].z * v[j].z + v[j].w * v[j].w); }
    s = wave_sum(s);
    if (lane == 0) rs1[row] = 1.0f / sqrtf(s * (1.0f / D) + EPS);
    u32x2* o = (u32x2*)(X1b + (size_t)row * D) + lane;
#pragma unroll
    for (int j = 0; j < 8; ++j) o[64 * j] = (u32x2){pk2(v[j].x, v[j].y), pk2(v[j].z, v[j].w)};
}
struct FixIn { bf16_t* ACT; const float *halo, *first, *cw, *cb; float* out; };
__global__ void __launch_bounds__(256) k_fixup(FixIn F) {
    const int i = blockIdx.x * 256 + threadIdx.x;
    if (i < 128 * 2 * DFF) {
        const int ch = i % DFF, rr = (i / DFF) & 1, q = i / (2 * DFF);
        const int qp = q == 0 ? 128 : q - 1;
        const float h0 = F.halo[((size_t)qp * 2 + 0) * DFF + ch], h1 = F.halo[((size_t)qp * 2 + 1) * DFF + ch];
        const float u0 = F.first[((size_t)(q * 2 + 0) * 2 + 0) * DFF + ch], u1 = F.first[((size_t)(q * 2 + 1) * 2 + 0) * DFF + ch];
        const float g = F.first[((size_t)(q * 2 + rr) * 2 + 1) * DFF + ch];
        const float um2 = rr == 0 ? h0 : h1, um1 = rr == 0 ? h1 : u0, uc = rr == 0 ? u0 : u1;
        const float a = gelu_tanh(F.cb[ch] + F.cw[ch] * um2 + F.cw[DFF + ch] * um1 + F.cw[2 * DFF + ch] * uc) * g;
        F.ACT[(size_t)(q * 64 + rr) * DFF + ch] = (bf16_t)f2bf(a);
    } else if (i < 128 * 2 * DFF + 2 * DFF) {
        const int e = i - 128 * 2 * DFF;
        F.out[O_PFC + e] = F.halo[(size_t)127 * 2 * DFF + e];
    }
}
__global__ void __launch_bounds__(512) k_final(float* out, const float* gfin) {
    const int r = blockIdx.x * 8 + (threadIdx.x >> 6), lane = threadIdx.x & 63;
    if (r >= NBIG + NSAMP) return;
    f32x4* y = (f32x4*)(out + (r < NBIG ? O_Y + (size_t)r * D : O_YS + (size_t)(r - NBIG) * D)) + lane;
    const f32x4* g = (const f32x4*)gfin + lane;
    f32x4 v[8]; float s = 0.f;
#pragma unroll
    for (int j = 0; j < 8; ++j) { v[j] = y[64 * j]; s += (v[j].x * v[j].x + v[j].y * v[j].y) + (v[j].z * v[j].z + v[j].w * v[j].w); }
    const float rs = 1.0f / sqrtf(wave_sum(s) * (1.0f / D) + EPS);
#pragma unroll
    for (int j = 0; j < 8; ++j) y[64 * j] = v[j] * rs * g[64 * j];
}

constexpr int GEMM_LDS = pg8::STAGE_BYTES + 1024;
template <class Epi>
__global__ void __launch_bounds__(512, 2) k_gemm(Gemm g, Epi E) {
    extern __shared__ __attribute__((aligned(16))) unsigned char lds[];
    pg8::StaticOrder S; S.init(g.M, g.N, (int)gridDim.x, (int)blockIdx.x);
    pg8::gemm_phase<Epi, pg8::StaticOrder, true, true>((LAS unsigned char*)lds, g, S, E);
}

extern "C" void kernel_launch(void* const* d_in, const int* in_sizes, int n_in, void* d_out, int out_size, void* d_ws, size_t ws_size, hipStream_t stream) {
    static int inited = 0;
    if (!inited) {
        inited = 1;
        if (n_in != 29 || out_size != (int)O_END || ws_size < WS_END) fprintf(stderr, "kernel_launch: unexpected shapes n_in %d out %d ws %zu (need %zu)\n", n_in, out_size, ws_size, (size_t)WS_END);
        (void)hipFuncSetAttribute((const void*)k_gemm<pg8::EpiZ>, hipFuncAttributeMaxDynamicSharedMemorySize, GEMM_LDS);
        (void)hipFuncSetAttribute((const void*)k_gemm<pg8::EpiRes>, hipFuncAttributeMaxDynamicSharedMemorySize, GEMM_LDS);
        (void)hipFuncSetAttribute((const void*)k_gemm<pg8::EpiUG>, hipFuncAttributeMaxDynamicSharedMemorySize, GEMM_LDS);
    }
    const float* const* in = (const float* const*)d_in;
    const float *x_prompt = in[0], *x_sample = in[1], *st_conv = in[2], *st_h = in[3], *cache_k = in[4], *cache_v = in[5], *st_ffn = in[6], *meta = in[7], *table = in[8],
                *norm_mix = in[9], *w_in = in[10], *conv_w = in[11], *conv_b = in[12], *ga_w = in[13], *ga_b = in[14], *gx_w = in[15], *gx_b = in[16], *lam = in[17], *sinks = in[18],
                *norm_rnn = in[19], *norm_attn = in[20], *w_out = in[21], *norm_ffn = in[22], *w_up = in[23], *w_gate = in[24], *fconv_w = in[25], *fconv_b = in[26], *w_down = in[27], *norm_final = in[28];
    unsigned char* ws = (unsigned char*)d_ws; float* out = (float*)d_out;
    bf16_t *Wt_in = (bf16_t*)(ws + WS_WIN), *Wt_out = (bf16_t*)(ws + WS_WOUT), *Wt_ug = (bf16_t*)(ws + WS_WUG), *Wt_dn = (bf16_t*)(ws + WS_WDN);
    bf16_t *H0 = (bf16_t*)(ws + WS_H0), *Z = (bf16_t*)(ws + WS_Z), *MIX = (bf16_t*)(ws + WS_MIX), *ACT = (bf16_t*)(ws + WS_ACT), *X1b = (bf16_t*)(ws + WS_X1B);
    float *XS = (float*)(ws + WS_XS), *rs1 = (float*)(ws + WS_RS1), *halo = (float*)(ws + WS_HALO), *first = (float*)(ws + WS_FIRST);

    XIn X; memset(&X, 0, sizeof X); X.xp = x_prompt; X.meta = meta; X.xsamp = x_sample;
    RowMap R; memset(&R, 0, sizeof R); R.out = out; R.xs = XS;
    WPrep P; memset(&P, 0, sizeof P);
    P.w_in = w_in; P.w_out = w_out; P.w_up = w_up; P.w_gate = w_gate; P.w_down = w_down; P.g_mix = norm_mix; P.g_rnn = norm_rnn; P.g_attn = norm_attn; P.g_ffn = norm_ffn;
    P.t_in = Wt_in; P.t_out = Wt_out; P.t_ug = Wt_ug; P.t_dn = Wt_dn;
    MixIn M; memset(&M, 0, sizeof M);
    M.Z = Z; M.R = R; M.st_conv = st_conv; M.st_h = st_h; M.cache_k = cache_k; M.cache_v = cache_v; M.conv_w = conv_w; M.conv_b = conv_b; M.ga_w = ga_w; M.ga_b = ga_b; M.gx_w = gx_w; M.gx_b = gx_b;
    M.lam = lam; M.sinks = sinks; M.table = table; M.out = out;

    hipLaunchKernelGGL(k_prep_weights, dim3(2048), dim3(256), 0, stream, P);
    hipLaunchKernelGGL(k_prep_rows, dim3(MP / 8), dim3(512), 0, stream, X, H0);
    { Gemm g; memset(&g, 0, sizeof g); g.A = H0; g.Bt = Wt_in; g.M = MP; g.N = DIN; g.K = D;
      pg8::EpiZ E; memset(&E, 0, sizeof E); E.O = Z; E.ldc = DIN;
      hipLaunchKernelGGL(k_gemm<pg8::EpiZ>, dim3(256), dim3(512), GEMM_LDS, stream, g, E); }
    hipLaunchKernelGGL(k_states, dim3((4194304 + 32768 + 3072 + 255) / 256), dim3(256), 0, stream, M);
    hipLaunchKernelGGL(k_rglru_seq, dim3(16 + NSAMP * 16), dim3(64), 0, stream, M);
    hipLaunchKernelGGL(k_attn_naive, dim3((TP + NSAMP) * 2), dim3(256), 0, stream, M);
    hipLaunchKernelGGL(k_mixnorm, dim3(MP / 8), dim3(512), 0, stream, R, MIX);
    { Gemm g; memset(&g, 0, sizeof g); g.A = MIX; g.Bt = Wt_out; g.M = MP; g.N = D; g.K = D;
      pg8::EpiRes E; memset(&E, 0, sizeof E); E.R = R; E.X = X; E.mode = 0;
      hipLaunchKernelGGL(k_gemm<pg8::EpiRes>, dim3(256), dim3(512), GEMM_LDS, stream, g, E); }
    hipLaunchKernelGGL(k_x1b, dim3(MP / 8), dim3(512), 0, stream, R, X1b, rs1);
    { Gemm g; memset(&g, 0, sizeof g); g.A = X1b; g.Bt = Wt_ug; g.M = MP; g.N = 2 * DFF; g.K = D;
      pg8::EpiUG E; memset(&E, 0, sizeof E); E.ACT = ACT; E.rs1 = rs1; E.cw = fconv_w; E.cb = fconv_b; E.st = st_ffn; E.halo = halo; E.first = first; E.out_sfc = out + O_SFC;
      hipLaunchKernelGGL(k_gemm<pg8::EpiUG>, dim3(256), dim3(512), GEMM_LDS, stream, g, E); }
    { FixIn F; memset(&F, 0, sizeof F); F.ACT = ACT; F.halo = halo; F.first = first; F.cw = fconv_w; F.cb = fconv_b; F.out = out;
      hipLaunchKernelGGL(k_fixup, dim3((128 * 2 * DFF + 2 * DFF + 255) / 256), dim3(256), 0, stream, F); }
    { Gemm g; memset(&g, 0, sizeof g); g.A = ACT; g.Bt = Wt_dn; g.M = MP; g.N = D; g.K = DFF;
      pg8::EpiRes E; memset(&E, 0, sizeof E); E.R = R; E.X = X; E.mode = 1;
      hipLaunchKernelGGL(k_gemm<pg8::EpiRes>, dim3(256), dim3(512), GEMM_LDS, stream, g, E); }
    hipLaunchKernelGGL(k_final, dim3((NBIG + NSAMP) / 8), dim3(512), 0, stream, out, norm_final);
}
```

```cpp
#include <hip/hip_runtime.h>
#include <hip/hip_cooperative_groups.h>
#include <cstdio>
#include <cstdint>
#include <cstring>

constexpr int D = 2048, NBIG = 8192, NMETA = 16, NSAMP = 128, TP = NBIG + NMETA  ;
constexpr int MROWS = NBIG + NMETA + NSAMP  , MP = 8448  ;
constexpr int DRNN = 1024, DATT = 1024, DIN = 3584, DFF = 6144, HD = 128, NH = 8, NKV = 2, WIN = 128;
constexpr int ZC_XR = 0, ZC_GR = 1024, ZC_Q = 2048, ZC_K = 3072, ZC_V = 3328;
constexpr int ROW_META = NBIG, ROW_SAMP = NBIG + NMETA;
constexpr float EPS = 1e-6f;
__host__ __device__ __forceinline__ int tok2row(int t) { return t >= NMETA ? t - NMETA : ROW_META + t; }

constexpr size_t O_Y = 0, O_YS = 16777216, O_PRC = 17039360, O_PRH = 17042432, O_PK = 17043456, O_PV = 17076224, O_PFC = 17108992,
                 O_SRC = 17121280, O_SRH = 17514496, O_SK = 17645568, O_SV = 21839872, O_SFC = 26034176, O_END = 27607040;

typedef unsigned short bf16_t;
typedef float f32x4 __attribute__((ext_vector_type(4)));
typedef float f32x2 __attribute__((ext_vector_type(2)));
typedef unsigned u32x4 __attribute__((ext_vector_type(4)));
typedef unsigned u32x2 __attribute__((ext_vector_type(2)));

__device__ __forceinline__ float bf2f(bf16_t b) { return __uint_as_float(((unsigned)b) << 16); }
__device__ __forceinline__ unsigned f2bf(float f) { unsigned u = __float_as_uint(f); return (u + 0x7fffu + ((u >> 16) & 1u)) >> 16; }
__device__ __forceinline__ unsigned pk2(float lo, float hi) { return f2bf(lo) | (f2bf(hi) << 16); }
__device__ __forceinline__ float wave_sum(float v) {
#pragma unroll
    for (int o = 1; o < 64; o <<= 1) v += __shfl_xor(v, o);
    return v;
}
__device__ __forceinline__ float wave_max(float v) {
#pragma unroll
    for (int o = 1; o < 64; o <<= 1) v = fmaxf(v, __shfl_xor(v, o));
    return v;
}
__device__ __forceinline__ float gelu_tanh(float x) {
    const float e = __builtin_amdgcn_exp2f(x * (1.0f + 0.044715f * x * x) * (-2.3022081985f));
    return x * __builtin_amdgcn_rcpf(1.0f + e);
}
__device__ __forceinline__ float sigmoid_f(float x) { return __builtin_amdgcn_rcpf(1.0f + __builtin_amdgcn_exp2f(x * (-1.4426950409f))); }

struct RowMap { float* out; float* xs; };
__device__ __forceinline__ float* xrow_ptr(const RowMap& R, int row) {
    if (row < NBIG) return R.out + O_Y + (size_t)row * D;
    if (row < ROW_SAMP) return R.xs + (size_t)(row - ROW_META) * D;
    if (row < MROWS) return R.out + O_YS + (size_t)(row - ROW_SAMP) * D;
    return nullptr;
}
struct XIn { const float* xp; const float* meta; const float* xsamp; };
__device__ __forceinline__ const float* xin_ptr(const XIn& X, int row) {
    if (row < NBIG) return X.xp + (size_t)row * D;
    if (row < ROW_SAMP) return X.meta + (size_t)(row - ROW_META) * D;
    if (row < MROWS) return X.xsamp + (size_t)(row - ROW_SAMP) * D;
    return nullptr;
}
namespace pg8 {
#define PG8_LAS __attribute__((address_space(3)))
typedef unsigned short bf16_t;
typedef short bf16x8 __attribute__((ext_vector_type(8)));
typedef float f32x4 __attribute__((ext_vector_type(4)));
typedef unsigned u32x4 __attribute__((ext_vector_type(4)));
constexpr int BM = 256, BK = 64, HALF = 128, HTB = HALF * BK * 2  , STAGE_BYTES = 8 * HTB, NXCD = 8, WGM = 8;

__host__ __device__ __forceinline__ int lds_byte(int r, int c) { const int st = (r >> 4) * 2 + (c >> 5), rr = r & 15, cc = c & 31, ob = rr * 64 + cc * 2; return st * 1024 + (ob ^ (((ob >> 9) & 1) << 5)); }
__host__ __device__ __forceinline__ void stage_rc(int b, int& R, int& C) { const int st = b / 1024, sb = b % 1024, swz = sb ^ (((sb >> 9) & 1) << 5); R = (st >> 1) * 16 + swz / 64; C = (st & 1) * 32 + (swz % 64) / 2; }
__host__ __device__ __forceinline__ int perm32(int rho) { const int n = rho >> 4, i = rho & 15; return 8 * (i >> 2) + 4 * n + (i & 3); }

struct Unit { int pm, pn; };
struct Gemm { const bf16_t* A; const bf16_t* Bt; int M, N, K; };

struct StaticOrder {
    int nM, nN, nwg, G, c;
    __host__ __device__ void init(int M, int N, int G_, int c_) { nM = M / BM; nN = N / BM; nwg = nM * nN; G = G_; c = c_; }
    __host__ __device__ bool next(int i, Unit& u) const {
        const long L = (long)i * G + c; if (L >= nwg) return false;
        int wgid = (int)L; { const int q = nwg / NXCD, r = nwg % NXCD, xcd = wgid % NXCD, off = wgid / NXCD; wgid = (xcd < r ? xcd * (q + 1) : r * (q + 1) + (xcd - r) * q) + off; }
        const int nig = WGM * nN, gid = wgid / nig, fm = gid * WGM, gsz = (nM - fm) < WGM ? (nM - fm) : WGM;
        u.pm = fm + ((wgid % nig) % gsz); u.pn = (wgid % nig) / gsz; return true;
    }
    __device__ __forceinline__ void a_ready(const Unit&) const {}
    __device__ __forceinline__ void done(const Unit&) const {}
};

__device__ __forceinline__ unsigned cvt_pk_bf16(float lo, float hi) { unsigned r; asm volatile("v_cvt_pk_bf16_f32 %0, %1, %2" : "=v"(r) : "v"(lo), "v"(hi)); return r; }

struct EpiZ {
    static constexpr bool PERM = true, AFTER_DRAIN = false;
    bf16_t* O; int ldc;
    __device__ __forceinline__ void operator()(const f32x4 (&acc)[2][2][4][2], const Unit& u, int wr, int wc, int fr, int fq) const {
        const int row0 = u.pm * BM + wr * 64 + fr, col0 = u.pn * BM + wc * 32 + 8 * fq;
#pragma unroll
        for (int ai = 0; ai < 2; ++ai)
#pragma unroll
            for (int m = 0; m < 4; ++m) { bf16_t* rowp = O + (size_t)(row0 + ai * HALF + m * 16) * ldc + col0;
#pragma unroll
                for (int bj = 0; bj < 2; ++bj) { const f32x4 v0 = acc[ai][bj][m][0], v1 = acc[ai][bj][m][1];
                    u32x4 w; w.x = cvt_pk_bf16(v0[0], v0[1]); w.y = cvt_pk_bf16(v0[2], v0[3]); w.z = cvt_pk_bf16(v1[0], v1[1]); w.w = cvt_pk_bf16(v1[2], v1[3]);
                    *(u32x4*)(rowp + bj * HALF) = w; } }
    }
};

struct EpiRes {
    static constexpr bool PERM = false, AFTER_DRAIN = false;
    RowMap R; XIn X; int mode; int pad_;
    __device__ __forceinline__ void operator()(const f32x4 (&acc)[2][2][4][2], const Unit& u, int wr, int wc, int fr, int fq) const {
        const int col0 = u.pn * BM + wc * 32 + 4 * fq;
#pragma unroll
        for (int ai = 0; ai < 2; ++ai)
#pragma unroll
            for (int m = 0; m < 4; ++m) {
                const int row = u.pm * BM + ai * HALF + wr * 64 + m * 16 + fr;
                float* d = xrow_ptr(R, row);
                if (d) {
                    const float* b = mode == 0 ? xin_ptr(X, row) : d;
#pragma unroll
                    for (int bj = 0; bj < 2; ++bj)
#pragma unroll
                        for (int n = 0; n < 2; ++n) { const int off = col0 + bj * HALF + n * 16; *(f32x4*)(d + off) = *(const f32x4*)(b + off) + acc[ai][bj][m][n]; }
                }
            }
    }
};

struct EpiUG {
    static constexpr bool PERM = true, AFTER_DRAIN = false;
    bf16_t* ACT; const float* rs1; const float* cw; const float* cb; const float* st; float* halo; float* first; float* out_sfc;
    __device__ __forceinline__ void operator()(const f32x4 (&acc)[2][2][4][2], const Unit& u, int wr, int wc, int fr, int fq) const {
        const int lane = (fq << 4) | fr;
        const int ch0 = u.pn * 128 + wc * 32 + 8 * fq;
        float w0[8], w1[8], w2[8], b0[8];
#pragma unroll
        for (int h = 0; h < 2; ++h) {
            const f32x4 a = *(const f32x4*)(cw + ch0 + 4 * h), b = *(const f32x4*)(cw + DFF + ch0 + 4 * h), c = *(const f32x4*)(cw + 2 * DFF + ch0 + 4 * h), d = *(const f32x4*)(cb + ch0 + 4 * h);
#pragma unroll
            for (int j = 0; j < 4; ++j) { w0[4 * h + j] = a[j]; w1[4 * h + j] = b[j]; w2[4 * h + j] = c[j]; b0[4 * h + j] = d[j]; }
        }
        const int src1 = (lane & 48) | ((fr + 15) & 15), src2 = (lane & 48) | ((fr + 14) & 15);
#pragma unroll
        for (int ai = 0; ai < 2; ++ai) {
            float pu[8];
#pragma unroll
            for (int e = 0; e < 8; ++e) pu[e] = 0.f;
#pragma unroll
            for (int m = 0; m < 4; ++m) {
                const int R0 = u.pm * BM + ai * HALF + wr * 64 + m * 16, row = R0 + fr;
                if (R0 >= MROWS) continue;
                const float rs = rs1[row];
                float uu[8], gg[8];
#pragma unroll
                for (int n = 0; n < 2; ++n)
#pragma unroll
                    for (int j = 0; j < 4; ++j) { uu[4 * n + j] = acc[ai][0][m][n][j] * rs; gg[4 * n + j] = acc[ai][1][m][n][j] * rs; }
                if (R0 < NBIG) {
                    float act[8];
#pragma unroll
                    for (int e = 0; e < 8; ++e) {
                        const float c1 = __shfl(uu[e], src1), c2 = __shfl(uu[e], src2), p1 = __shfl(pu[e], src1), p2 = __shfl(pu[e], src2);
                        const float um1 = fr >= 1 ? c1 : p1, um2 = fr >= 2 ? c2 : p2;
                        act[e] = gelu_tanh(b0[e] + w0[e] * um2 + w1[e] * um1 + w2[e] * uu[e]) * gg[e];
                    }
                    const int q = R0 >> 6;
                    if (m == 0 && fr < 2) {
                        float* f = first + ((size_t)(q * 2 + fr) * 2) * DFF + ch0;
                        *(f32x4*)(f) = (f32x4){uu[0], uu[1], uu[2], uu[3]}; *(f32x4*)(f + 4) = (f32x4){uu[4], uu[5], uu[6], uu[7]};
                        *(f32x4*)(f + DFF) = (f32x4){gg[0], gg[1], gg[2], gg[3]}; *(f32x4*)(f + DFF + 4) = (f32x4){gg[4], gg[5], gg[6], gg[7]};
                    } else {
                        u32x4 w; w.x = cvt_pk_bf16(act[0], act[1]); w.y = cvt_pk_bf16(act[2], act[3]); w.z = cvt_pk_bf16(act[4], act[5]); w.w = cvt_pk_bf16(act[6], act[7]);
                        *(u32x4*)(ACT + (size_t)row * DFF + ch0) = w;
                    }
                    if (m == 3 && fr >= 14) {
                        float* f = halo + ((size_t)q * 2 + (fr - 14)) * DFF + ch0;
                        *(f32x4*)(f) = (f32x4){uu[0], uu[1], uu[2], uu[3]}; *(f32x4*)(f + 4) = (f32x4){uu[4], uu[5], uu[6], uu[7]};
                    }
#pragma unroll
                    for (int e = 0; e < 8; ++e) pu[e] = uu[e];
                } else if (R0 == ROW_META) {
                    if (fr >= 14) {
                        float* f = halo + ((size_t)128 * 2 + (fr - 14)) * DFF + ch0;
                        *(f32x4*)(f) = (f32x4){uu[0], uu[1], uu[2], uu[3]}; *(f32x4*)(f + 4) = (f32x4){uu[4], uu[5], uu[6], uu[7]};
                    }
                } else {
                    const int b = row - ROW_SAMP;
                    const float* s0p = st + ((size_t)b * 2) * DFF + ch0; const float* s1p = s0p + DFF;
                    const f32x4 s0a = *(const f32x4*)s0p, s0b = *(const f32x4*)(s0p + 4), s1a = *(const f32x4*)s1p, s1b = *(const f32x4*)(s1p + 4);
                    float act[8];
#pragma unroll
                    for (int e = 0; e < 8; ++e) {
                        const float h0 = e < 4 ? s0a[e & 3] : s0b[e & 3], h1 = e < 4 ? s1a[e & 3] : s1b[e & 3];
                        act[e] = gelu_tanh(b0[e] + w0[e] * h0 + w1[e] * h1 + w2[e] * uu[e]) * gg[e];
                    }
                    u32x4 w; w.x = cvt_pk_bf16(act[0], act[1]); w.y = cvt_pk_bf16(act[2], act[3]); w.z = cvt_pk_bf16(act[4], act[5]); w.w = cvt_pk_bf16(act[6], act[7]);
                    *(u32x4*)(ACT + (size_t)row * DFF + ch0) = w;
                    float* o = out_sfc + ((size_t)b * 2) * DFF + ch0;
                    *(f32x4*)(o) = s1a; *(f32x4*)(o + 4) = s1b;
                    *(f32x4*)(o + DFF) = (f32x4){uu[0], uu[1], uu[2], uu[3]}; *(f32x4*)(o + DFF + 4) = (f32x4){uu[4], uu[5], uu[6], uu[7]};
                }
            }
        }
    }
};

template <class Epi, class Sched, bool ALIGN_EPI = false, bool SP2 = false>
__device__ __forceinline__ void gemm_phase(PG8_LAS unsigned char* lds, const Gemm g, const Sched& S, const Epi& E) {
    int tid_ = threadIdx.x; asm volatile("" : "+v"(tid_));
    const int tid = tid_, wid = __builtin_amdgcn_readfirstlane(tid >> 6), lane = tid & 63, wr = wid >> 2, wc = wid & 3, fr = lane & 15, fq = lane >> 4;
    const int K = g.K, nt = K / BK;
    unsigned voffA[2], voffB[2];
#pragma unroll
    for (int i = 0; i < 2; ++i) { int R, C; stage_rc(tid * 16 + i * 8192, R, C); const int Rb = Epi::PERM ? ((R & ~31) + perm32(R & 31)) : R;
        voffA[i] = (unsigned)(R * K + C) * 2u; voffB[i] = (unsigned)(Rb * K + C) * 2u; }
    const size_t kstep = (size_t)(BK * 2);
    const size_t hstep = (size_t)HALF * K * 2;
    const size_t tstep = 2 * hstep;
    const unsigned ldsw = (unsigned)wid * 1024u;
    const int aoff = lds_byte(wr * 64 + fr, fq * 8), boff = lds_byte(wc * 32 + fr, fq * 8);
#define PG8_SA(b, h) (((b) * 2 + (h)) * HTB)
#define PG8_SB(b, h) ((4 + (b) * 2 + (h)) * HTB)
#define PG8_STAGE(bufoff, gbase, voff) do { _Pragma("unroll") for (int _i = 0; _i < 2; ++_i) \
        __builtin_amdgcn_global_load_lds((const unsigned*)((const char*)(gbase) + (voff)[_i]), (PG8_LAS unsigned*)(lds + (bufoff) + ldsw + _i * 8192), 16, 0, 0); } while (0)
#define PG8_LDA(dst, b, h) do { _Pragma("unroll") for (int m = 0; m < 4; ++m) _Pragma("unroll") for (int k = 0; k < 2; ++k) dst[m][k] = *(const PG8_LAS bf16x8*)(lds + PG8_SA(b, h) + aoff + m * 2048 + k * 1024); } while (0)
#define PG8_LDB(dst, b, h) do { _Pragma("unroll") for (int n = 0; n < 2; ++n) _Pragma("unroll") for (int k = 0; k < 2; ++k) dst[n][k] = *(const PG8_LAS bf16x8*)(lds + PG8_SB(b, h) + boff + n * 2048 + k * 1024); } while (0)
#define PG8_MMA(ai, bj, At, Bt) do { __builtin_amdgcn_s_setprio(1); _Pragma("unroll") for (int m = 0; m < 4; ++m) _Pragma("unroll") for (int n = 0; n < 2; ++n) _Pragma("unroll") for (int k = 0; k < 2; ++k) \
        acc[ai][bj][m][n] = __builtin_amdgcn_mfma_f32_16x16x32_bf16(Bt[n][k], At[m][k], acc[ai][bj][m][n], 0, 0, 0); __builtin_amdgcn_s_setprio(0); } while (0)
#define PG8_WAIT_V(n) asm volatile("s_waitcnt vmcnt(" #n ")" ::: "memory")
#define PG8_WAIT_L(n) asm volatile("s_waitcnt lgkmcnt(" #n ")" ::: "memory")
#define PG8_BAR __builtin_amdgcn_s_barrier()
#define PG8_SCHED __builtin_amdgcn_sched_barrier(0)
    Unit cur, nxt; int ui = 0;
    if (!S.next(0, cur)) return;
    f32x4 acc[2][2][4][2];
#pragma unroll
    for (int a = 0; a < 2; ++a)
#pragma unroll
        for (int b = 0; b < 2; ++b)
#pragma unroll
            for (int m = 0; m < 4; ++m)
#pragma unroll
                for (int n = 0; n < 2; ++n) acc[a][b][m][n] = (f32x4){0.f, 0.f, 0.f, 0.f};
    bf16x8 At[4][2], B0[2][2], B1[2][2];
    const char* cA = (const char*)g.A + (size_t)cur.pm * tstep; const char* cB = (const char*)g.Bt + (size_t)cur.pn * tstep;
    S.a_ready(cur);
    if constexpr (SP2) {
        PG8_STAGE(PG8_SB(0, 0), cB, voffB); PG8_STAGE(PG8_SB(0, 1), cB + hstep, voffB); PG8_STAGE(PG8_SA(0, 0), cA, voffA); PG8_STAGE(PG8_SA(0, 1), cA + hstep, voffA);
        if (wr == 1) PG8_BAR;
        PG8_WAIT_V(2); PG8_BAR;
        PG8_STAGE(PG8_SB(1, 0), cB + kstep, voffB); PG8_STAGE(PG8_SA(1, 0), cA + kstep, voffA); PG8_STAGE(PG8_SB(1, 1), cB + hstep + kstep, voffB);
        PG8_WAIT_V(6); PG8_BAR;
    } else {
        PG8_STAGE(PG8_SB(0, 0), cB, voffB); PG8_STAGE(PG8_SA(0, 0), cA, voffA); PG8_STAGE(PG8_SB(0, 1), cB + hstep, voffB); PG8_STAGE(PG8_SA(0, 1), cA + hstep, voffA);
        if (wr == 1) PG8_BAR;
        PG8_WAIT_V(4); PG8_BAR;
        PG8_STAGE(PG8_SB(1, 0), cB + kstep, voffB); PG8_STAGE(PG8_SA(1, 0), cA + kstep, voffA); PG8_STAGE(PG8_SB(1, 1), cB + hstep + kstep, voffB);
        PG8_WAIT_V(6); PG8_BAR;
    }
    for (;;) {
        const bool has_next = S.next(ui + 1, nxt);
        const char* nA = has_next ? (const char*)g.A + (size_t)nxt.pm * tstep : cA; const char* nB = has_next ? (const char*)g.Bt + (size_t)nxt.pn * tstep : cB;
        for (int t = 0; t < nt; t += 2) {
            const bool last = (t == nt - 2);
            const char* a1 = cA + (size_t)(t + 1) * kstep;
            const char* a2 = last ? nA : cA + (size_t)(t + 2) * kstep; const char* b2 = last ? nB : cB + (size_t)(t + 2) * kstep;
            const char* a3 = a2 + kstep; const char* b3 = b2 + kstep;
            if (last && has_next) S.a_ready(nxt);
            if constexpr (SP2) {
            PG8_LDB(B0, 0, 0); PG8_LDB(B1, 0, 1); PG8_SCHED; PG8_LDA(At, 0, 0); PG8_STAGE(PG8_SA(1, 1), a1 + hstep, voffA);
            PG8_WAIT_V(8); PG8_WAIT_L(0); PG8_BAR; PG8_MMA(0, 0, At, B0); PG8_MMA(0, 1, At, B1); PG8_BAR; PG8_SCHED;
            PG8_LDA(At, 0, 1); PG8_STAGE(PG8_SB(0, 0), b2, voffB); PG8_STAGE(PG8_SB(0, 1), b2 + hstep, voffB); PG8_STAGE(PG8_SA(0, 0), a2, voffA);
            PG8_WAIT_V(8); PG8_WAIT_L(0); PG8_BAR; PG8_MMA(1, 0, At, B0); PG8_MMA(1, 1, At, B1); PG8_BAR; PG8_SCHED;
            PG8_LDB(B0, 1, 0); PG8_LDB(B1, 1, 1); PG8_SCHED; PG8_LDA(At, 1, 0); PG8_STAGE(PG8_SA(0, 1), a2 + hstep, voffA);
            PG8_WAIT_V(8); PG8_WAIT_L(0); PG8_BAR; PG8_MMA(0, 0, At, B0); PG8_MMA(0, 1, At, B1); PG8_BAR; PG8_SCHED;
            PG8_LDA(At, 1, 1); PG8_STAGE(PG8_SB(1, 0), b3, voffB); PG8_STAGE(PG8_SB(1, 1), b3 + hstep, voffB); PG8_STAGE(PG8_SA(1, 0), a3, voffA);
            PG8_WAIT_V(8); PG8_WAIT_L(0); PG8_BAR; PG8_MMA(1, 0, At, B0); PG8_MMA(1, 1, At, B1); PG8_BAR; PG8_SCHED;
            } else {
            PG8_LDB(B0, 0, 0); PG8_SCHED; PG8_LDA(At, 0, 0); PG8_STAGE(PG8_SA(1, 1), a1 + hstep, voffA);
            PG8_WAIT_L(8); PG8_BAR; PG8_WAIT_L(0); PG8_MMA(0, 0, At, B0); PG8_BAR; PG8_SCHED;
            PG8_LDB(B1, 0, 1); PG8_STAGE(PG8_SB(0, 0), b2, voffB);
            PG8_BAR; PG8_WAIT_L(0); PG8_MMA(0, 1, At, B1); PG8_BAR;
            PG8_LDA(At, 0, 1); PG8_STAGE(PG8_SA(0, 0), a2, voffA);
            PG8_BAR; PG8_WAIT_L(0); PG8_MMA(1, 0, At, B0); PG8_BAR; PG8_SCHED;
            PG8_STAGE(PG8_SB(0, 1), b2 + hstep, voffB);
            PG8_WAIT_V(6); PG8_BAR; PG8_MMA(1, 1, At, B1); PG8_BAR;
            PG8_LDB(B0, 1, 0); PG8_SCHED; PG8_LDA(At, 1, 0); PG8_STAGE(PG8_SA(0, 1), a2 + hstep, voffA);
            PG8_WAIT_L(8); PG8_BAR; PG8_WAIT_L(0); PG8_MMA(0, 0, At, B0); PG8_BAR; PG8_SCHED;
            PG8_LDB(B1, 1, 1); PG8_STAGE(PG8_SB(1, 0), b3, voffB);
            PG8_BAR; PG8_WAIT_L(0); PG8_MMA(0, 1, At, B1); PG8_BAR;
            PG8_LDA(At, 1, 1); PG8_STAGE(PG8_SA(1, 0), a3, voffA);
            PG8_BAR; PG8_WAIT_L(0); PG8_MMA(1, 0, At, B0); PG8_BAR; PG8_SCHED;
            PG8_STAGE(PG8_SB(1, 1), b3 + hstep, voffB);
            PG8_WAIT_V(6); PG8_BAR; PG8_MMA(1, 1, At, B1); PG8_BAR;
            }
        }
        if constexpr (ALIGN_EPI) { if (wr == 0) PG8_BAR; }
        if constexpr (!Epi::AFTER_DRAIN) { E(acc, cur, wr, wc, fr, fq); S.done(cur); }
        if (!has_next) break;
#pragma unroll
        for (int a = 0; a < 2; ++a)
#pragma unroll
            for (int b = 0; b < 2; ++b)
#pragma unroll
                for (int m = 0; m < 4; ++m)
#pragma unroll
                    for (int n = 0; n < 2; ++n) acc[a][b][m][n] = (f32x4){0.f, 0.f, 0.f, 0.f};
        cur = nxt; cA = nA; cB = nB; ++ui;
        if constexpr (ALIGN_EPI) { if (wr == 1) PG8_BAR; }
    }
    PG8_WAIT_V(0);
    if constexpr (!ALIGN_EPI) { if (wr == 0) PG8_BAR; }
    PG8_BAR;
    if constexpr (Epi::AFTER_DRAIN) { E.fused(acc, cur, wr, wc, fr, fq, lds, wid, lane); S.done(cur); }
#undef PG8_SA
#undef PG8_SB
#undef PG8_STAGE
#undef PG8_LDA
#undef PG8_LDB
#undef PG8_MMA
#undef PG8_WAIT_V
#undef PG8_WAIT_L
#undef PG8_BAR
#undef PG8_SCHED
}
}

using pg8::Gemm;
#define LAS __attribute__((address_space(3)))

constexpr size_t MiB = 1u << 20;
constexpr size_t WS_CTL = 0;
constexpr size_t WS_WIN = 1 * MiB;
constexpr size_t WS_WOUT = WS_WIN + (size_t)DIN * D * 2;
constexpr size_t WS_WUG = WS_WOUT + (size_t)D * D * 2;
constexpr size_t WS_WDN = WS_WUG + (size_t)2 * DFF * D * 2;
constexpr size_t WS_R1 = WS_WDN + (size_t)D * DFF * 2;
constexpr size_t WS_H0 = WS_R1;
constexpr size_t WS_Z = WS_H0 + (size_t)MP * D * 2;
constexpr size_t WS_MIX = WS_Z + (size_t)MP * DIN * 2;
constexpr size_t WS_ACT = WS_R1;
constexpr size_t WS_R1_END = WS_MIX + (size_t)MP * D * 2;
constexpr size_t WS_X1B = WS_R1_END;
constexpr size_t WS_XS = WS_X1B + (size_t)MP * D * 2;
constexpr size_t WS_RS1 = WS_XS + (size_t)64 * D * 4;
constexpr size_t WS_HALO = WS_RS1 + (size_t)MP * 4;
constexpr size_t WS_FIRST = WS_HALO + (size_t)129 * 2 * DFF * 4;
constexpr size_t WS_GWF = WS_FIRST + (size_t)128 * 4 * DFF * 4;
constexpr size_t WS_SUMA = WS_GWF + (size_t)16384 * 16;
constexpr size_t WS_SUMB = WS_SUMA + (size_t)65 * 1024 * 4;
constexpr size_t WS_END = WS_SUMB + (size_t)65 * 1024 * 4;
static_assert(WS_ACT + (size_t)MP * DFF * 2 <= WS_R1_END, "ACT overlay fits in H0|Z|MIX");
static_assert(WS_END <= 308053024, "workspace map must fit the guaranteed d_ws size");


namespace cg = cooperative_groups;
struct Params {
    const float *x_prompt, *x_sample, *st_conv, *st_h, *cache_k, *cache_v, *st_ffn, *meta, *table, *norm_mix, *w_in, *conv_w, *conv_b, *ga_w, *ga_b, *gx_w, *gx_b, *lam, *sinks,
                *norm_rnn, *norm_attn, *w_out, *norm_ffn, *w_up, *w_gate, *fconv_w, *fconv_b, *w_down, *norm_final;
    float* out; unsigned char* ws;
};
__device__ __forceinline__ void prep_row(const XIn& X, bf16_t* H0, int row, int lane) {
    u32x2* o = (u32x2*)(H0 + (size_t)row * D) + lane;
    const float* src = xin_ptr(X, row);
    if (!src) {
#pragma unroll
        for (int j = 0; j < 8; ++j) o[64 * j] = (u32x2){0u, 0u};
        return;
    }
    const f32x4* xr = (const f32x4*)src + lane;
    f32x4 v[8]; float s = 0.f;
#pragma unroll
    for (int j = 0; j < 8; ++j) { v[j] = xr[64 * j]; s += (v[j].x * v[j].x + v[j].y * v[j].y) + (v[j].z * v[j].z + v[j].w * v[j].w); }
    const float rs = 1.0f / sqrtf(wave_sum(s) * (1.0f / D) + EPS);
#pragma unroll
    for (int j = 0; j < 8; ++j) o[64 * j] = (u32x2){pk2(v[j].x * rs, v[j].y * rs), pk2(v[j].z * rs, v[j].w * rs)};
}
__device__ __forceinline__ void mixnorm_row(const RowMap& R, bf16_t* MIX, int row, int lane) {
    const f32x4* y = (const f32x4*)xrow_ptr(R, row) + lane;
    f32x4 v[8]; float s0 = 0.f, s1 = 0.f;
#pragma unroll
    for (int j = 0; j < 8; ++j) { v[j] = y[64 * j]; const float q = (v[j].x * v[j].x + v[j].y * v[j].y) + (v[j].z * v[j].z + v[j].w * v[j].w); if (j < 4) s0 += q; else s1 += q; }
    const float r0 = 1.0f / sqrtf(wave_sum(s0) * (1.0f / DRNN) + EPS), r1 = 1.0f / sqrtf(wave_sum(s1) * (1.0f / DATT) + EPS);
    u32x2* o = (u32x2*)(MIX + (size_t)row * D) + lane;
#pragma unroll
    for (int j = 0; j < 8; ++j) { const float r = j < 4 ? r0 : r1; o[64 * j] = (u32x2){pk2(v[j].x * r, v[j].y * r), pk2(v[j].z * r, v[j].w * r)}; }
}
__device__ __forceinline__ void x1b_row(const RowMap& R, bf16_t* X1b, float* rs1, int row, int lane) {
    const f32x4* y = (const f32x4*)xrow_ptr(R, row) + lane;
    f32x4 v[8]; float s = 0.f;
#pragma unroll
    for (int j = 0; j < 8; ++j) { v[j] = y[64 * j]; s += (v[j].x * v[j].x + v[j].y * v[j].y) + (v[j].z * v[j].z + v[j].w * v[j].w); }
    s = wave_sum(s);
    if (lane == 0) rs1[row] = 1.0f / sqrtf(s * (1.0f / D) + EPS);
    u32x2* o = (u32x2*)(X1b + (size_t)row * D) + lane;
#pragma unroll
    for (int j = 0; j < 8; ++j) o[64 * j] = (u32x2){pk2(v[j].x, v[j].y), pk2(v[j].z, v[j].w)};
}
__device__ __forceinline__ void final_row(float* out, const float* gfin, int r, int lane) {
    f32x4* y = (f32x4*)(out + (r < NBIG ? O_Y + (size_t)r * D : O_YS + (size_t)(r - NBIG) * D)) + lane;
    const f32x4* g = (const f32x4*)gfin + lane;
    f32x4 v[8]; float s = 0.f;
#pragma unroll
    for (int j = 0; j < 8; ++j) { v[j] = y[64 * j]; s += (v[j].x * v[j].x + v[j].y * v[j].y) + (v[j].z * v[j].z + v[j].w * v[j].w); }
    const float rs = 1.0f / sqrtf(wave_sum(s) * (1.0f / D) + EPS);
#pragma unroll
    for (int j = 0; j < 8; ++j) y[64 * j] = v[j] * rs * g[64 * j];
}
struct WPrep { const float *w_in, *w_out, *w_up, *w_gate, *w_down, *g_mix, *g_rnn, *g_attn, *g_ffn; bf16_t *t_in, *t_out, *t_ug, *t_dn; };
constexpr int WT_IN = (D / 64) * (DIN / 64), WT_OUT = (D / 64) * (D / 64), WT_UP = (D / 64) * (DFF / 64), WT_DN = (DFF / 64) * (D / 64);
constexpr int WT_TOTAL = WT_IN + WT_OUT + 2 * WT_UP + WT_DN;
static_assert(WT_TOTAL % 2 == 0, "two tiles per block iteration");
__device__ __forceinline__ void wprep_tile(const WPrep& P, int it, LAS float* s  , int tid) {
    const float* W; bf16_t* Wt; int K, N, job;
    if (it < WT_IN) { job = 0; W = P.w_in; Wt = P.t_in; K = D; N = DIN; }
    else if ((it -= WT_IN) < WT_OUT) { job = 1; W = P.w_out; Wt = P.t_out; K = D; N = D; }
    else if ((it -= WT_OUT) < WT_UP) { job = 2; W = P.w_up; Wt = P.t_ug; K = D; N = DFF; }
    else if ((it -= WT_UP) < WT_UP) { job = 3; W = P.w_gate; Wt = P.t_ug; K = D; N = DFF; }
    else { it -= WT_UP; job = 4; W = P.w_down; Wt = P.t_dn; K = DFF; N = D; }
    const int nblk = N / 64, kb = it / nblk, nb = it % nblk, k0 = kb * 64, n0 = nb * 64;
    {
        const int nn = tid & 63, kq = tid >> 6;
#pragma unroll 4
        for (int i = 0; i < 16; ++i) {
            const int kk = kq + 4 * i, k = k0 + kk;
            float g = 1.0f;
            if (job == 0) g = P.g_mix[k]; else if (job == 1) g = k < DRNN ? P.g_rnn[k] : P.g_attn[k - DRNN]; else if (job == 2 || job == 3) g = P.g_ffn[k];
            s[kk * 65 + nn] = W[(size_t)k * N + n0 + nn] * g;
        }
    }
    __syncthreads();
#pragma unroll
    for (int h = 0; h < 2; ++h) {
        const int n = tid >> 2, c = (tid & 3) + 4 * h, ng = n0 + n;
        int drow = ng;
        if (job == 2) drow = 256 * (ng >> 7) + (ng & 127); else if (job == 3) drow = 256 * (ng >> 7) + 128 + (ng & 127);
        const LAS float* sp = s + (8 * c) * 65 + n;
        u32x4 o; o.x = pk2(sp[0], sp[65]); o.y = pk2(sp[2 * 65], sp[3 * 65]); o.z = pk2(sp[4 * 65], sp[5 * 65]); o.w = pk2(sp[6 * 65], sp[7 * 65]);
        *(u32x4*)(Wt + (size_t)drow * K + k0 + 8 * c) = o;
    }
    __syncthreads();
}
__device__ __forceinline__ int rel_bucket(int d) {
    if (d < 16) return d;
    const int l = 16 + (int)(logf((float)d * (1.0f / 16.0f)) / 2.0794415417f * 16.0f);
    return l < 31 ? l : 31;
}

typedef short bf16x8 __attribute__((ext_vector_type(8)));
typedef float f32x16 __attribute__((ext_vector_type(16)));
constexpr int NCHUNK = 65;
struct ScanIn {
    const bf16_t* Z; RowMap R;
    const float *st_conv, *st_h, *conv_w, *conv_b, *ga_b, *gx_b, *lam;
    const u32x4* gwf;
    float *sumA, *sumB;
    float* out;
};
__device__ __forceinline__ void prep_gwf_frag(const float* ga_w, const float* gx_w, u32x4* gwf, int i) {
    const int lane = i & 63, s = (i >> 6) & 3, nb = (i >> 8) & 1, gate = (i >> 9) & 1, blk = i >> 10;
    const float* W = (gate ? gx_w : ga_w) + (size_t)blk * 64 * 64;
    const int n = 32 * nb + (lane & 31), k0 = 16 * s + 8 * (lane >> 5);
    u32x4 o; o.x = pk2(W[(k0 + 0) * 64 + n], W[(k0 + 1) * 64 + n]); o.y = pk2(W[(k0 + 2) * 64 + n], W[(k0 + 3) * 64 + n]);
    o.z = pk2(W[(k0 + 4) * 64 + n], W[(k0 + 5) * 64 + n]); o.w = pk2(W[(k0 + 6) * 64 + n], W[(k0 + 7) * 64 + n]);
    gwf[i] = o;
}
__device__ __forceinline__ float bflo(unsigned w) { return __uint_as_float(w << 16); }
__device__ __forceinline__ float bfhi(unsigned w) { return __uint_as_float(w & 0xffff0000u); }

template <int MODE>
__device__ __forceinline__ void gate_preact(const ScanIn& S, int blk, int t0, int b0, int lane, f32x16& pa0, f32x16& pa1, f32x16& px0, f32x16& px1) {
    const int tt = lane & 31, hh = lane >> 5;
    f32x16 aa0 = {}, aa1 = {}, ax0 = {}, ax1 = {};
#pragma unroll 1
    for (int s = 0; s < 4; ++s) {
        const int ch = 64 * blk + 16 * s + 8 * hh;
        float xc[8];
        { const f32x4 c0 = *(const f32x4*)(S.conv_b + ch), c1 = *(const f32x4*)(S.conv_b + ch + 4);
#pragma unroll
          for (int e = 0; e < 4; ++e) { xc[e] = c0[e]; xc[4 + e] = c1[e]; } }
#pragma unroll
        for (int j = 0; j < 4; ++j) {
            const f32x4 w0 = *(const f32x4*)(S.conv_w + j * DRNN + ch), w1 = *(const f32x4*)(S.conv_w + j * DRNN + ch + 4);
            float xv[8];
            if (MODE == 2 && j < 3) {
                const float* sp = S.st_conv + ((size_t)(b0 + tt) * 3 + j) * DRNN + ch;
                const f32x4 a = *(const f32x4*)sp, b = *(const f32x4*)(sp + 4);
#pragma unroll
                for (int e = 0; e < 4; ++e) { xv[e] = a[e]; xv[4 + e] = b[e]; }
            } else {
                const int t = t0 + tt - 3 + j;
                const int row = MODE == 2 ? ROW_SAMP + b0 + tt : tok2row(t < 0 ? 0 : t);
                u32x4 q = *(const u32x4*)(S.Z + (size_t)row * DIN + ZC_XR + ch);
                if (MODE != 2 && t < 0) q = (u32x4){0u, 0u, 0u, 0u};
                xv[0] = bflo(q.x); xv[1] = bfhi(q.x); xv[2] = bflo(q.y); xv[3] = bfhi(q.y); xv[4] = bflo(q.z); xv[5] = bfhi(q.z); xv[6] = bflo(q.w); xv[7] = bfhi(q.w);
            }
#pragma unroll
            for (int e = 0; e < 4; ++e) { xc[e] += w0[e] * xv[e]; xc[4 + e] += w1[e] * xv[4 + e]; }
        }
        u32x4 ap; ap.x = pk2(xc[0], xc[1]); ap.y = pk2(xc[2], xc[3]); ap.z = pk2(xc[4], xc[5]); ap.w = pk2(xc[6], xc[7]);
        const bf16x8 A = __builtin_bit_cast(bf16x8, ap);
        const u32x4* g = S.gwf + ((size_t)(blk * 2) * 2 * 4 + s) * 64 + lane;
        const bf16x8 Ba0 = __builtin_bit_cast(bf16x8, g[0]), Ba1 = __builtin_bit_cast(bf16x8, g[4 * 64]), Bx0 = __builtin_bit_cast(bf16x8, g[8 * 64]), Bx1 = __builtin_bit_cast(bf16x8, g[12 * 64]);
        aa0 = __builtin_amdgcn_mfma_f32_32x32x16_bf16(A, Ba0, aa0, 0, 0, 0);
        aa1 = __builtin_amdgcn_mfma_f32_32x32x16_bf16(A, Ba1, aa1, 0, 0, 0);
        ax0 = __builtin_amdgcn_mfma_f32_32x32x16_bf16(A, Bx0, ax0, 0, 0, 0);
        ax1 = __builtin_amdgcn_mfma_f32_32x32x16_bf16(A, Bx1, ax1, 0, 0, 0);
    }
#pragma unroll
    for (int i = 0; i < 16; ++i) {
        auto r = __builtin_amdgcn_permlane32_swap(__float_as_uint(aa0[i]), __float_as_uint(aa1[i]), false, false);
        pa0[i] = __uint_as_float(r[0]); pa1[i] = __uint_as_float(r[1]);
        auto q = __builtin_amdgcn_permlane32_swap(__float_as_uint(ax0[i]), __float_as_uint(ax1[i]), false, false);
        px0[i] = __uint_as_float(q[0]); px1[i] = __uint_as_float(q[1]);
    }
}

struct ChanConst { float cw0, cw1, cw2, cw3, cb, ba, bx, csp; };
__device__ __forceinline__ ChanConst chan_const(const ScanIn& S, int c) {
    ChanConst k; k.cw0 = S.conv_w[c]; k.cw1 = S.conv_w[DRNN + c]; k.cw2 = S.conv_w[2 * DRNN + c]; k.cw3 = S.conv_w[3 * DRNN + c]; k.cb = S.conv_b[c];
    k.ba = S.ga_b[c]; k.bx = S.gx_b[c];
    const float lam = S.lam[c];
    k.csp = 8.0f * (fmaxf(-lam, 0.f) + log1pf(expf(-fabsf(lam))));
    return k;
}
__device__ __forceinline__ void lru_ab(const ChanConst& k, float pa, float px, float xc, float& a, float& b) {
    const float r = sigmoid_f(pa + k.ba), ig = sigmoid_f(px + k.bx);
    const float la = -k.csp * r;
    a = __expf(la);
    b = sqrtf(-expm1f(2.0f * la)) * ig * xc;
}

template <int PASS>
__device__ __forceinline__ void rglru_chunk(const ScanIn& S, int k, int half, int wave, int lane) {
    const int blk = 8 * half + wave, c = 64 * blk + lane;
    const ChanConst kc = chan_const(S, c);
    const int nsub = k == 0 ? 1 : 4, tbase = k == 0 ? 0 : 16 + 128 * (k - 1);
    float h = 0.f, P = 1.f;
    if (PASS == 1) {
        for (int k0 = 0; k0 < k; k0 += 8) {
            float A[8], B[8];
#pragma unroll
            for (int u = 0; u < 8; ++u) { const int kk = k0 + u < k ? k0 + u : k - 1; A[u] = S.sumA[(size_t)kk * DRNN + c]; B[u] = S.sumB[(size_t)kk * DRNN + c]; }
#pragma unroll
            for (int u = 0; u < 8; ++u) { const bool v = k0 + u < k; h = (v ? A[u] : 1.f) * h + (v ? B[u] : 0.f); }
        }
    }
    float x3, x2, x1;
    { const int ta = tbase - 3, tb = tbase - 2, tc = tbase - 1;
      x3 = ta >= 0 ? bf2f(S.Z[(size_t)tok2row(ta) * DIN + ZC_XR + c]) : 0.f;
      x2 = tb >= 0 ? bf2f(S.Z[(size_t)tok2row(tb) * DIN + ZC_XR + c]) : 0.f;
      x1 = tc >= 0 ? bf2f(S.Z[(size_t)tok2row(tc) * DIN + ZC_XR + c]) : 0.f; }
    for (int sc = 0; sc < nsub; ++sc) {
        const int t0 = tbase + 32 * sc;
        f32x16 pa0, pa1, px0, px1;
        gate_preact<0>(S, blk, t0, 0, lane, pa0, pa1, px0, px1);
        float xr[32], gr[32];
#pragma unroll
        for (int tt = 0; tt < 32; ++tt) {
            const int row = tok2row(t0 + tt);
            xr[tt] = bf2f(S.Z[(size_t)row * DIN + ZC_XR + c]);
            if (PASS == 1) gr[tt] = bf2f(S.Z[(size_t)row * DIN + ZC_GR + c]);
        }
        const int nv = k == 0 ? 16 : 32;
#pragma unroll
        for (int tt = 0; tt < 32; ++tt) {
            if (tt < nv) {
                const int g = tt >> 3, hh = (tt >> 2) & 1, j = tt & 3;
                const float pa = hh ? pa1[4 * g + j] : pa0[4 * g + j], px = hh ? px1[4 * g + j] : px0[4 * g + j];
                const float xc = kc.cb + kc.cw0 * x3 + kc.cw1 * x2 + kc.cw2 * x1 + kc.cw3 * xr[tt];
                x3 = x2; x2 = x1; x1 = xr[tt];
                float a, b; lru_ab(kc, pa, px, xc, a, b);
                h = a * h + b;
                if (PASS == 0) P *= a;
                if (PASS == 1) xrow_ptr(S.R, tok2row(t0 + tt))[c] = h * gelu_tanh(gr[tt]);
            }
        }
    }
    if (PASS == 0) { S.sumA[(size_t)k * DRNN + c] = P; S.sumB[(size_t)k * DRNN + c] = h; }
    if (PASS == 1 && k == NCHUNK - 1) S.out[O_PRH + c] = h;
}
__device__ __forceinline__ void rglru_sample(const ScanIn& S, int sb, int half, int wave, int lane) {
    const int blk = 8 * half + wave, c = 64 * blk + lane, b0 = 32 * sb;
    const ChanConst kc = chan_const(S, c);
    f32x16 pa0, pa1, px0, px1;
    gate_preact<2>(S, blk, 0, b0, lane, pa0, pa1, px0, px1);
#pragma unroll
    for (int tt = 0; tt < 32; ++tt) {
        const int b = b0 + tt, row = ROW_SAMP + b;
        const int g = tt >> 3, hh = (tt >> 2) & 1, j = tt & 3;
        const float pa = hh ? pa1[4 * g + j] : pa0[4 * g + j], px = hh ? px1[4 * g + j] : px0[4 * g + j];
        const float s0 = S.st_conv[((size_t)b * 3 + 0) * DRNN + c], s1 = S.st_conv[((size_t)b * 3 + 1) * DRNN + c], s2 = S.st_conv[((size_t)b * 3 + 2) * DRNN + c];
        const float xn = bf2f(S.Z[(size_t)row * DIN + ZC_XR + c]), gr = bf2f(S.Z[(size_t)row * DIN + ZC_GR + c]);
        const float xc = kc.cb + kc.cw0 * s0 + kc.cw1 * s1 + kc.cw2 * s2 + kc.cw3 * xn;
        float a, bb; lru_ab(kc, pa, px, xc, a, bb);
        const float h = a * S.st_h[(size_t)b * DRNN + c] + bb;
        xrow_ptr(S.R, row)[c] = h * gelu_tanh(gr);
        S.out[O_SRH + (size_t)b * DRNN + c] = h;
        S.out[O_SRC + ((size_t)b * 3 + 0) * DRNN + c] = s1; S.out[O_SRC + ((size_t)b * 3 + 1) * DRNN + c] = s2; S.out[O_SRC + ((size_t)b * 3 + 2) * DRNN + c] = xn;
    }
}

constexpr int AT_K_OFF = 0, AT_VT_OFF = 49152, AT_VT_STRIDE = 392, AT_BIAS_OFF = AT_VT_OFF + 128 * AT_VT_STRIDE  , AT_LDS = AT_BIAS_OFF + 2048;
constexpr int N_QB = 129;
constexpr float ATT_SCALE = 0.08838834764831845f;
struct AttnIn { const bf16_t* Z; RowMap R; const float *cache_k, *cache_v, *sinks, *table; float* out; };

__device__ __forceinline__ void attn_prompt_unit(const AttnIn& A, LAS unsigned char* lds, int kvh, int qb, int tid) {
    const int wave = __builtin_amdgcn_readfirstlane(tid >> 6), lane = tid & 63, g = wave >> 1, qh = wave & 1, h = 4 * kvh + g;
    const int ql = lane & 31, hh = lane >> 5;
    const int tk0 = 64 * qb - 128;
#pragma unroll
    for (int i = 0; i < 6; ++i) {
        const int id = tid + 512 * i, key = id >> 4, c = id & 15, tk = tk0 + key;
        u32x4 kq = (u32x4){0u, 0u, 0u, 0u}, vq = (u32x4){0u, 0u, 0u, 0u};
        if (tk >= 0 && tk < TP) {
            const bf16_t* zr = A.Z + (size_t)tok2row(tk) * DIN + kvh * HD + 8 * c;
            kq = *(const u32x4*)(zr + ZC_K); vq = *(const u32x4*)(zr + ZC_V);
        }
        *(LAS u32x4*)(lds + AT_K_OFF + key * 256 + ((c ^ (key & 15)) << 4)) = kq;
        LAS unsigned short* vt = (LAS unsigned short*)(lds + AT_VT_OFF + (8 * c) * AT_VT_STRIDE + 2 * key);
        vt[0 * (AT_VT_STRIDE / 2)] = (unsigned short)(vq.x & 0xffffu); vt[1 * (AT_VT_STRIDE / 2)] = (unsigned short)(vq.x >> 16);
        vt[2 * (AT_VT_STRIDE / 2)] = (unsigned short)(vq.y & 0xffffu); vt[3 * (AT_VT_STRIDE / 2)] = (unsigned short)(vq.y >> 16);
        vt[4 * (AT_VT_STRIDE / 2)] = (unsigned short)(vq.z & 0xffffu); vt[5 * (AT_VT_STRIDE / 2)] = (unsigned short)(vq.z >> 16);
        vt[6 * (AT_VT_STRIDE / 2)] = (unsigned short)(vq.w & 0xffffu); vt[7 * (AT_VT_STRIDE / 2)] = (unsigned short)(vq.w >> 16);
    }
    { const int gg = tid >> 7, dist = tid & 127; ((LAS float*)(lds + AT_BIAS_OFF))[tid] = A.table[rel_bucket(dist) * NH + 4 * kvh + gg]; }
    const int tq = 64 * qb + 32 * qh + ql;
    bf16x8 bq[8];
    { const bf16_t* qp = A.Z + (size_t)tok2row(tq < TP ? tq : TP - 1) * DIN + ZC_Q + h * HD + 8 * hh;
#pragma unroll
      for (int s = 0; s < 8; ++s) bq[s] = __builtin_bit_cast(bf16x8, *(const u32x4*)(qp + 16 * s)); }
    __syncthreads();
    f32x16 st[5];
#pragma unroll
    for (int kb = 0; kb < 5; ++kb) {
        const int kk = 32 * (qh + kb) + ql;
        f32x16 acc = {};
#pragma unroll
        for (int s = 0; s < 8; ++s) {
            const bf16x8 ka = __builtin_bit_cast(bf16x8, *(const LAS u32x4*)(lds + AT_K_OFF + kk * 256 + (((2 * s + hh) ^ (kk & 15)) << 4)));
            acc = __builtin_amdgcn_mfma_f32_32x32x16_bf16(ka, bq[s], acc, 0, 0, 0);
        }
        st[kb] = acc;
    }
    const LAS float* sb = (const LAS float*)(lds + AT_BIAS_OFF) + g * 128;
    const float sink = A.sinks[h];
    float mx = -1e30f;
#pragma unroll
    for (int kb = 0; kb < 5; ++kb)
#pragma unroll
        for (int i = 0; i < 16; ++i) {
            const int r = (i & 3) + 8 * (i >> 2) + 4 * hh;
            const int dist = 128 + ql - 32 * kb - r, tk = tk0 + 32 * (qh + kb) + r;
            const bool ok = dist >= 0 && dist < 128 && tk >= 0;
            const float l = ok ? st[kb][i] * ATT_SCALE + sb[dist & 127] : -1e30f;
            st[kb][i] = l; mx = fmaxf(mx, l);
        }
    mx = fmaxf(fmaxf(mx, __shfl_xor(mx, 32)), sink);
    float sum = 0.f;
#pragma unroll
    for (int kb = 0; kb < 5; ++kb)
#pragma unroll
        for (int i = 0; i < 16; ++i) { const float p = st[kb][i] > -1e29f ? __expf(st[kb][i] - mx) : 0.f; st[kb][i] = p; sum += p; }
    sum += __shfl_xor(sum, 32);
    sum += __expf(sink - mx);
    const float inv = 1.0f / sum;
    f32x16 ot[4] = {};
#pragma unroll
    for (int kb = 0; kb < 5; ++kb)
#pragma unroll
        for (int s2 = 0; s2 < 2; ++s2) {
            u32x4 pp; pp.x = pk2(st[kb][8 * s2 + 0], st[kb][8 * s2 + 1]); pp.y = pk2(st[kb][8 * s2 + 2], st[kb][8 * s2 + 3]);
            pp.z = pk2(st[kb][8 * s2 + 4], st[kb][8 * s2 + 5]); pp.w = pk2(st[kb][8 * s2 + 6], st[kb][8 * s2 + 7]);
            const bf16x8 pf = __builtin_bit_cast(bf16x8, pp);
            const int kk0 = 32 * (qh + kb) + 16 * s2 + 4 * hh;
#pragma unroll
            for (int db = 0; db < 4; ++db) {
                const LAS unsigned char* vp = lds + AT_VT_OFF + (32 * db + ql) * AT_VT_STRIDE + 2 * kk0;
                const u32x2 lo = *(const LAS u32x2*)vp, hi = *(const LAS u32x2*)(vp + 16);
                const bf16x8 va = __builtin_bit_cast(bf16x8, (u32x4){lo.x, lo.y, hi.x, hi.y});
                ot[db] = __builtin_amdgcn_mfma_f32_32x32x16_bf16(va, pf, ot[db], 0, 0, 0);
            }
        }
    if (tq < TP) {
        float* y = xrow_ptr(A.R, tok2row(tq)) + DRNN + h * HD + 4 * hh;
#pragma unroll
        for (int db = 0; db < 4; ++db)
#pragma unroll
            for (int g4 = 0; g4 < 4; ++g4)
                *(f32x4*)(y + 32 * db + 8 * g4) = (f32x4){ot[db][4 * g4] * inv, ot[db][4 * g4 + 1] * inv, ot[db][4 * g4 + 2] * inv, ot[db][4 * g4 + 3] * inv};
    }
    __syncthreads();
}

__device__ __forceinline__ void attn_sample_item(const AttnIn& A, LAS unsigned char* lds, int b, int kvh, int tid) {
    LAS float* sq = (LAS float*)lds;
    LAS float* sl = sq + 512;
    LAS float* so = sl + 512;
    const int row = ROW_SAMP + b, lane = tid & 63, wave = tid >> 6;
    { const int gg = tid >> 7, d = tid & 127; sq[tid] = bf2f(A.Z[(size_t)row * DIN + ZC_Q + (4 * kvh + gg) * HD + d]) * ATT_SCALE; }
    __syncthreads();
    {
        const int w = tid >> 2, part = tid & 3, d0 = 32 * part;
        float kv[32];
        if (w < 127) {
            const f32x4* kp = (const f32x4*)(A.cache_k + (((size_t)b * WIN + w + 1) * NKV + kvh) * HD + d0);
#pragma unroll
            for (int e = 0; e < 8; ++e) { const f32x4 v = kp[e]; kv[4 * e] = v.x; kv[4 * e + 1] = v.y; kv[4 * e + 2] = v.z; kv[4 * e + 3] = v.w; }
        } else {
            const u32x4* kp = (const u32x4*)(A.Z + (size_t)row * DIN + ZC_K + kvh * HD + d0);
#pragma unroll
            for (int e = 0; e < 4; ++e) { const u32x4 q = kp[e]; kv[8 * e] = bflo(q.x); kv[8 * e + 1] = bfhi(q.x); kv[8 * e + 2] = bflo(q.y); kv[8 * e + 3] = bfhi(q.y);
                kv[8 * e + 4] = bflo(q.z); kv[8 * e + 5] = bfhi(q.z); kv[8 * e + 6] = bflo(q.w); kv[8 * e + 7] = bfhi(q.w); }
        }
        f32x4* ko = (f32x4*)(A.out + O_SK + (((size_t)b * WIN + w) * NKV + kvh) * HD + d0);
#pragma unroll
        for (int e = 0; e < 8; ++e) ko[e] = (f32x4){kv[4 * e], kv[4 * e + 1], kv[4 * e + 2], kv[4 * e + 3]};
        float dt[4] = {0.f, 0.f, 0.f, 0.f};
#pragma unroll
        for (int e = 0; e < 32; ++e) {
#pragma unroll
            for (int gg = 0; gg < 4; ++gg) dt[gg] += sq[gg * 128 + d0 + e] * kv[e];
        }
#pragma unroll
        for (int gg = 0; gg < 4; ++gg) { dt[gg] += __shfl_xor(dt[gg], 1); dt[gg] += __shfl_xor(dt[gg], 2); }
        const float mine = part == 0 ? dt[0] : part == 1 ? dt[1] : part == 2 ? dt[2] : dt[3];
        sl[part * 128 + w] = mine + A.table[rel_bucket(127 - w) * NH + 4 * kvh + part];
    }
    __syncthreads();
    if (wave < 4) {
        const float sink = A.sinks[4 * kvh + wave];
        const float l0 = sl[wave * 128 + lane], l1 = sl[wave * 128 + 64 + lane];
        const float mx = fmaxf(wave_max(fmaxf(l0, l1)), sink);
        const float e0 = __expf(l0 - mx), e1 = __expf(l1 - mx);
        const float inv = 1.0f / (wave_sum(e0 + e1) + __expf(sink - mx));
        sl[wave * 128 + lane] = e0 * inv; sl[wave * 128 + 64 + lane] = e1 * inv;
    }
    __syncthreads();
    {
        const int d = tid & 127, qt = tid >> 7;
        float acc[4] = {0.f, 0.f, 0.f, 0.f};
#pragma unroll 8
        for (int i = 0; i < 32; ++i) {
            const int w = 32 * qt + i;
            const float v = w < 127 ? A.cache_v[(((size_t)b * WIN + w + 1) * NKV + kvh) * HD + d] : bf2f(A.Z[(size_t)row * DIN + ZC_V + kvh * HD + d]);
            A.out[O_SV + (((size_t)b * WIN + w) * NKV + kvh) * HD + d] = v;
#pragma unroll
            for (int gg = 0; gg < 4; ++gg) acc[gg] += sl[gg * 128 + w] * v;
        }
#pragma unroll
        for (int gg = 0; gg < 4; ++gg) so[(qt * 4 + gg) * 128 + d] = acc[gg];
    }
    __syncthreads();
    { const int gg = tid >> 7, d = tid & 127;
      xrow_ptr(A.R, row)[DRNN + (4 * kvh + gg) * HD + d] = so[(0 * 4 + gg) * 128 + d] + so[(1 * 4 + gg) * 128 + d] + so[(2 * 4 + gg) * 128 + d] + so[(3 * 4 + gg) * 128 + d]; }
    __syncthreads();
}

__device__ __forceinline__ void prompt_states(const bf16_t* Z, float* out, int tid) {
    for (int e = tid; e < 32768; e += 512) {
        const int d = e & 127, kvh = (e >> 7) & 1, wi = e >> 8;
        const bf16_t* z = Z + (size_t)tok2row(TP - WIN + wi) * DIN + kvh * HD + d;
        out[O_PK + e] = bf2f(z[ZC_K]); out[O_PV + e] = bf2f(z[ZC_V]);
    }
    for (int e = tid; e < 3072; e += 512) { const int c = e & 1023, j = e >> 10; out[O_PRC + e] = bf2f(Z[(size_t)tok2row(TP - 3 + j) * DIN + ZC_XR + c]); }
}
__device__ __forceinline__ void fixup_elem(bf16_t* ACT, const float* halo, const float* first, const float* cw, const float* cb, float* out, int i) {
    if (i < 128 * 2 * DFF) {
        const int ch = i % DFF, rr = (i / DFF) & 1, q = i / (2 * DFF);
        const int qp = q == 0 ? 128 : q - 1;
        const float h0 = halo[((size_t)qp * 2 + 0) * DFF + ch], h1 = halo[((size_t)qp * 2 + 1) * DFF + ch];
        const float u0 = first[((size_t)(q * 2 + 0) * 2 + 0) * DFF + ch], u1 = first[((size_t)(q * 2 + 1) * 2 + 0) * DFF + ch];
        const float g = first[((size_t)(q * 2 + rr) * 2 + 1) * DFF + ch];
        const float um2 = rr == 0 ? h0 : h1, um1 = rr == 0 ? h1 : u0, uc = rr == 0 ? u0 : u1;
        const float a = gelu_tanh(cb[ch] + cw[ch] * um2 + cw[DFF + ch] * um1 + cw[2 * DFF + ch] * uc) * g;
        ACT[(size_t)(q * 64 + rr) * DFF + ch] = (bf16_t)f2bf(a);
    } else if (i < 128 * 2 * DFF + 2 * DFF) {
        const int e = i - 128 * 2 * DFF;
        out[O_PFC + e] = halo[(size_t)127 * 2 * DFF + e];
    }
}

constexpr int LDS_BYTES = 147456;
static_assert(pg8::STAGE_BYTES <= LDS_BYTES && AT_LDS <= LDS_BYTES, "LDS map");
__global__ void __launch_bounds__(512, 2) mega(Params p) {
    extern __shared__ __attribute__((aligned(16))) unsigned char lds_raw[];
    LAS unsigned char* lds = (LAS unsigned char*)lds_raw;
    cg::grid_group grid = cg::this_grid();
    const int tid = threadIdx.x, lane = tid & 63, wave = __builtin_amdgcn_readfirstlane(tid >> 6), bid = blockIdx.x, G = gridDim.x;
    unsigned char* ws = p.ws; float* out = p.out;
    bf16_t *Wt_in = (bf16_t*)(ws + WS_WIN), *Wt_out = (bf16_t*)(ws + WS_WOUT), *Wt_ug = (bf16_t*)(ws + WS_WUG), *Wt_dn = (bf16_t*)(ws + WS_WDN);
    bf16_t *H0 = (bf16_t*)(ws + WS_H0), *Z = (bf16_t*)(ws + WS_Z), *MIX = (bf16_t*)(ws + WS_MIX), *ACT = (bf16_t*)(ws + WS_ACT), *X1b = (bf16_t*)(ws + WS_X1B);
    float *XS = (float*)(ws + WS_XS), *rs1 = (float*)(ws + WS_RS1), *halo = (float*)(ws + WS_HALO), *first = (float*)(ws + WS_FIRST);
    XIn X; X.xp = p.x_prompt; X.meta = p.meta; X.xsamp = p.x_sample;
    RowMap R; R.out = out; R.xs = XS;

    {
        WPrep W; W.w_in = p.w_in; W.w_out = p.w_out; W.w_up = p.w_up; W.w_gate = p.w_gate; W.w_down = p.w_down; W.g_mix = p.norm_mix; W.g_rnn = p.norm_rnn; W.g_attn = p.norm_attn; W.g_ffn = p.norm_ffn;
        W.t_in = Wt_in; W.t_out = Wt_out; W.t_ug = Wt_ug; W.t_dn = Wt_dn;
        const int half = tid >> 8;
        LAS float* s = (LAS float*)(lds + half * 16896);
        for (int it = 2 * bid; it < WT_TOTAL; it += 2 * G) wprep_tile(W, it + half, s, tid & 255);
        for (int i = bid * 512 + tid; i < 16384; i += G * 512) prep_gwf_frag(p.ga_w, p.gx_w, (u32x4*)(ws + WS_GWF), i);
        for (int row = bid * 8 + wave; row < MP; row += G * 8) prep_row(X, H0, row, lane);
    }
    grid.sync();
    {
        Gemm g; g.A = H0; g.Bt = Wt_in; g.M = MP; g.N = DIN; g.K = D;
        pg8::StaticOrder S; S.init(MP, DIN, G, bid);
        pg8::EpiZ E; E.O = Z; E.ldc = DIN;
        pg8::gemm_phase<pg8::EpiZ, pg8::StaticOrder, true, true>(lds, g, S, E);
    }
    grid.sync();
    ScanIn SI; SI.Z = Z; SI.R = R; SI.st_conv = p.st_conv; SI.st_h = p.st_h; SI.conv_w = p.conv_w; SI.conv_b = p.conv_b; SI.ga_b = p.ga_b; SI.gx_b = p.gx_b; SI.lam = p.lam;
    SI.gwf = (const u32x4*)(ws + WS_GWF); SI.sumA = (float*)(ws + WS_SUMA); SI.sumB = (float*)(ws + WS_SUMB); SI.out = out;
    {
        AttnIn A; A.Z = Z; A.R = R; A.cache_k = p.cache_k; A.cache_v = p.cache_v; A.sinks = p.sinks; A.table = p.table; A.out = out;
        for (int it = bid; it < 2 * N_QB; it += G) attn_prompt_unit(A, lds, it & 1, it >> 1, tid);
        for (int it = bid; it < 2 * NSAMP; it += G) attn_sample_item(A, lds, it >> 1, it & 1, tid);
        for (int it = G - 1 - bid; it < 2 * NCHUNK; it += G) rglru_chunk<0>(SI, it >> 1, it & 1, wave, lane);
        if (bid == (G > 2 ? 2 : 0)) prompt_states(Z, out, tid);
    }
    grid.sync();
    {
        for (int it = bid; it < 2 * NCHUNK + 8; it += G) {
            if (it < 2 * NCHUNK) rglru_chunk<1>(SI, it >> 1, it & 1, wave, lane);
            else rglru_sample(SI, (it - 2 * NCHUNK) >> 1, (it - 2 * NCHUNK) & 1, wave, lane);
        }
    }
    grid.sync();
    for (int row = bid * 8 + wave; row < MROWS; row += G * 8) mixnorm_row(R, MIX, row, lane);
    grid.sync();
    {
        Gemm g; g.A = MIX; g.Bt = Wt_out; g.M = MP; g.N = D; g.K = D;
        pg8::StaticOrder S; S.init(MP, D, G, bid);
        pg8::EpiRes E; E.R = R; E.X = X; E.mode = 0; E.pad_ = 0;
        pg8::gemm_phase<pg8::EpiRes, pg8::StaticOrder, true, true>(lds, g, S, E);
    }
    grid.sync();
    for (int row = bid * 8 + wave; row < MROWS; row += G * 8) x1b_row(R, X1b, rs1, row, lane);
    grid.sync();
    {
        Gemm g; g.A = X1b; g.Bt = Wt_ug; g.M = MP; g.N = 2 * DFF; g.K = D;
        pg8::StaticOrder S; S.init(MP, 2 * DFF, G, bid);
        pg8::EpiUG E; E.ACT = ACT; E.rs1 = rs1; E.cw = p.fconv_w; E.cb = p.fconv_b; E.st = p.st_ffn; E.halo = halo; E.first = first; E.out_sfc = out + O_SFC;
        pg8::gemm_phase<pg8::EpiUG, pg8::StaticOrder, true, true>(lds, g, S, E);
    }
    grid.sync();
    for (int i = bid * 512 + tid; i < 128 * 2 * DFF + 2 * DFF; i += G * 512) fixup_elem(ACT, halo, first, p.fconv_w, p.fconv_b, out, i);
    grid.sync();
    {
        Gemm g; g.A = ACT; g.Bt = Wt_dn; g.M = MP; g.N = D; g.K = DFF;
        pg8::StaticOrder S; S.init(MP, D, G, bid);
        pg8::EpiRes E; E.R = R; E.X = X; E.mode = 1; E.pad_ = 0;
        pg8::gemm_phase<pg8::EpiRes, pg8::StaticOrder, true, true>(lds, g, S, E);
    }
    grid.sync();
    for (int r = bid * 8 + wave; r < NBIG + NSAMP; r += G * 8) final_row(out, p.norm_final, r, lane);
}

extern "C" void kernel_launch(void* const* d_in, const int* in_sizes, int n_in, void* d_out, int out_size, void* d_ws, size_t ws_size, hipStream_t stream) {
    static int grid = 0;
    if (grid == 0) {
        if (n_in != 29 || out_size != (int)O_END || ws_size < WS_END) fprintf(stderr, "kernel_launch: unexpected shapes n_in %d out %d ws %zu (need %zu)\n", n_in, out_size, ws_size, (size_t)WS_END);
        int dev = 0, cus = 0, per_cu = 0;
        (void)hipGetDevice(&dev);
        (void)hipDeviceGetAttribute(&cus, hipDeviceAttributeMultiprocessorCount, dev);
        (void)hipFuncSetAttribute((const void*)mega, hipFuncAttributeMaxDynamicSharedMemorySize, LDS_BYTES);
        (void)hipOccupancyMaxActiveBlocksPerMultiprocessor(&per_cu, (const void*)mega, 512, LDS_BYTES);
        if (per_cu < 1) { fprintf(stderr, "kernel_launch: occupancy query says %d blocks per CU\n", per_cu); per_cu = 1; }
        grid = cus * per_cu;
        if (grid <= 0) grid = 256;
    }
    Params p; memset(&p, 0, sizeof p);
    const float* const* in = (const float* const*)d_in;
    p.x_prompt = in[0]; p.x_sample = in[1]; p.st_conv = in[2]; p.st_h = in[3]; p.cache_k = in[4]; p.cache_v = in[5]; p.st_ffn = in[6]; p.meta = in[7]; p.table = in[8];
    p.norm_mix = in[9]; p.w_in = in[10]; p.conv_w = in[11]; p.conv_b = in[12]; p.ga_w = in[13]; p.ga_b = in[14]; p.gx_w = in[15]; p.gx_b = in[16]; p.lam = in[17]; p.sinks = in[18];
    p.norm_rnn = in[19]; p.norm_attn = in[20]; p.w_out = in[21]; p.norm_ffn = in[22]; p.w_up = in[23]; p.w_gate = in[24]; p.fconv_w = in[25]; p.fconv_b = in[26]; p.w_down = in[27]; p.norm_final = in[28];
    p.out = (float*)d_out; p.ws = (unsigned char*)d_ws;
    void* args[] = {&p};
    hipError_t e = hipLaunchCooperativeKernel((const void*)mega, dim3(grid), dim3(512), args, LDS_BYTES, stream);
    if (e != hipSuccess) fprintf(stderr, "kernel_launch: cooperative launch failed: %s (grid %d)\n", hipGetErrorString(e), grid);
}
```

```cpp
#include <hip/hip_runtime.h>
#include <hip/hip_cooperative_groups.h>
#include <cstdio>
#include <cstdint>
#include <cstring>

constexpr int D = 2048, NBIG = 8192, NMETA = 16, NSAMP = 128, TP = NBIG + NMETA  ;
constexpr int MROWS = NBIG + NMETA + NSAMP  , MP = 8448  ;
constexpr int DRNN = 1024, DATT = 1024, DIN = 3584, DFF = 6144, HD = 128, NH = 8, NKV = 2, WIN = 128;
constexpr int ZC_XR = 0, ZC_GR = 1024, ZC_Q = 2048, ZC_K = 3072, ZC_V = 3328;
constexpr int ROW_META = NBIG, ROW_SAMP = NBIG + NMETA;
constexpr float EPS = 1e-6f;
__host__ __device__ __forceinline__ int tok2row(int t) { return t >= NMETA ? t - NMETA : ROW_META + t; }

constexpr size_t O_Y = 0, O_YS = 16777216, O_PRC = 17039360, O_PRH = 17042432, O_PK = 17043456, O_PV = 17076224, O_PFC = 17108992,
                 O_SRC = 17121280, O_SRH = 17514496, O_SK = 17645568, O_SV = 21839872, O_SFC = 26034176, O_END = 27607040;

typedef unsigned short bf16_t;
typedef float f32x4 __attribute__((ext_vector_type(4)));
typedef float f32x2 __attribute__((ext_vector_type(2)));
typedef unsigned u32x4 __attribute__((ext_vector_type(4)));
typedef unsigned u32x2 __attribute__((ext_vector_type(2)));

__device__ __forceinline__ float bf2f(bf16_t b) { return __uint_as_float(((unsigned)b) << 16); }
__device__ __forceinline__ unsigned f2bf(float f) { unsigned u = __float_as_uint(f); return (u + 0x7fffu + ((u >> 16) & 1u)) >> 16; }
__device__ __forceinline__ unsigned pk2(float lo, float hi) { return f2bf(lo) | (f2bf(hi) << 16); }
template <int XM> __device__ __forceinline__ float swz_xor(float v) {
    return __int_as_float(__builtin_amdgcn_ds_swizzle(__float_as_int(v), (XM << 10) | 0x1f)); }
__device__ __forceinline__ float sum_x32(float v) { auto r = __builtin_amdgcn_permlane32_swap(__float_as_uint(v), __float_as_uint(v), false, false); return __uint_as_float(r[0]) + __uint_as_float(r[1]); }
__device__ __forceinline__ float max_x32(float v) { auto r = __builtin_amdgcn_permlane32_swap(__float_as_uint(v), __float_as_uint(v), false, false); return fmaxf(__uint_as_float(r[0]), __uint_as_float(r[1])); }
__device__ __forceinline__ float wave_sum(float v) {
    v += swz_xor<1>(v); v += swz_xor<2>(v); v += swz_xor<4>(v); v += swz_xor<8>(v); v += swz_xor<16>(v);
    return sum_x32(v);
}
__device__ __forceinline__ float wave_max(float v) {
    v = fmaxf(v, swz_xor<1>(v)); v = fmaxf(v, swz_xor<2>(v)); v = fmaxf(v, swz_xor<4>(v)); v = fmaxf(v, swz_xor<8>(v)); v = fmaxf(v, swz_xor<16>(v));
    return max_x32(v);
}
__device__ __forceinline__ float gelu_tanh(float x) {
    const float e = __builtin_amdgcn_exp2f(x * (1.0f + 0.044715f * x * x) * (-2.3022081985f));
    return x * __builtin_amdgcn_rcpf(1.0f + e);
}
__device__ __forceinline__ float sigmoid_f(float x) { return __builtin_amdgcn_rcpf(1.0f + __builtin_amdgcn_exp2f(x * (-1.4426950409f))); }

struct RowMap { float* out; float* xs; };
__device__ __forceinline__ float* xrow_ptr(const RowMap& R, int row) {
    if (row < NBIG) return R.out + O_Y + (size_t)row * D;
    if (row < ROW_SAMP) return R.xs + (size_t)(row - ROW_META) * D;
    if (row < MROWS) return R.out + O_YS + (size_t)(row - ROW_SAMP) * D;
    return nullptr;
}
struct XIn { const float* xp; const float* meta; const float* xsamp; };
__device__ __forceinline__ const float* xin_ptr(const XIn& X, int row) {
    if (row < NBIG) return X.xp + (size_t)row * D;
    if (row < ROW_SAMP) return X.meta + (size_t)(row - ROW_META) * D;
    if (row < MROWS) return X.xsamp + (size_t)(row - ROW_SAMP) * D;
    return nullptr;
}
namespace pg8 {
#define PG8_LAS __attribute__((address_space(3)))
typedef unsigned short bf16_t;
typedef short bf16x8 __attribute__((ext_vector_type(8)));
typedef float f32x4 __attribute__((ext_vector_type(4)));
typedef unsigned u32x4 __attribute__((ext_vector_type(4)));
constexpr int BM = 256, BK = 64, HALF = 128, HTB = HALF * BK * 2  , STAGE_BYTES = 8 * HTB, NXCD = 8, WGM = 8;

__host__ __device__ __forceinline__ int lds_byte(int r, int c) { const int st = (r >> 4) * 2 + (c >> 5), rr = r & 15, cc = c & 31, ob = rr * 64 + cc * 2; return st * 1024 + (ob ^ (((ob >> 9) & 1) << 5)); }
__host__ __device__ __forceinline__ void stage_rc(int b, int& R, int& C) { const int st = b / 1024, sb = b % 1024, swz = sb ^ (((sb >> 9) & 1) << 5); R = (st >> 1) * 16 + swz / 64; C = (st & 1) * 32 + (swz % 64) / 2; }
__host__ __device__ __forceinline__ int perm32(int rho) { const int n = rho >> 4, i = rho & 15; return 8 * (i >> 2) + 4 * n + (i & 3); }

struct Unit { int pm, pn; };
struct Gemm { const bf16_t* A; const bf16_t* Bt; int M, N, K; };

struct StaticOrder {
    int nM, nN, nwg, G, c;
    __host__ __device__ void init(int M, int N, int G_, int c_) { nM = M / BM; nN = N / BM; nwg = nM * nN; G = G_; c = c_; }
    __host__ __device__ bool next(int i, Unit& u) const {
        const long L = (long)i * G + c; if (L >= nwg) return false;
        int wgid = (int)L; { const int q = nwg / NXCD, r = nwg % NXCD, xcd = wgid % NXCD, off = wgid / NXCD; wgid = (xcd < r ? xcd * (q + 1) : r * (q + 1) + (xcd - r) * q) + off; }
        const int nig = WGM * nN, gid = wgid / nig, fm = gid * WGM, gsz = (nM - fm) < WGM ? (nM - fm) : WGM;
        u.pm = fm + ((wgid % nig) % gsz); u.pn = (wgid % nig) / gsz; return true;
    }
    __device__ __forceinline__ void a_ready(const Unit&) const {}
    __device__ __forceinline__ void done(const Unit&) const {}
};

__device__ __forceinline__ unsigned cvt_pk_bf16(float lo, float hi) { unsigned r; asm volatile("v_cvt_pk_bf16_f32 %0, %1, %2" : "=v"(r) : "v"(lo), "v"(hi)); return r; }

struct EpiZ {
    static constexpr bool PERM = true, AFTER_DRAIN = false, MIDK = false;
    bf16_t* O; int ldc;
    __device__ __forceinline__ void operator()(const f32x4 (&acc)[2][2][4][2], const Unit& u, int wr, int wc, int fr, int fq) const {
        const int row0 = u.pm * BM + wr * 64 + fr, col0 = u.pn * BM + wc * 32 + 8 * fq;
#pragma unroll
        for (int ai = 0; ai < 2; ++ai)
#pragma unroll
            for (int m = 0; m < 4; ++m) { bf16_t* rowp = O + (size_t)(row0 + ai * HALF + m * 16) * ldc + col0;
#pragma unroll
                for (int bj = 0; bj < 2; ++bj) { const f32x4 v0 = acc[ai][bj][m][0], v1 = acc[ai][bj][m][1];
                    u32x4 w; w.x = cvt_pk_bf16(v0[0], v0[1]); w.y = cvt_pk_bf16(v0[2], v0[3]); w.z = cvt_pk_bf16(v1[0], v1[1]); w.w = cvt_pk_bf16(v1[2], v1[3]);
                    *(u32x4*)(rowp + bj * HALF) = w; } }
    }
};

struct EpiRes {
    static constexpr bool PERM = false, AFTER_DRAIN = false, MIDK = false;
    RowMap R; XIn X; int mode; int pad_;
    __device__ __forceinline__ void operator()(const f32x4 (&acc)[2][2][4][2], const Unit& u, int wr, int wc, int fr, int fq) const {
        const int col0 = u.pn * BM + wc * 32 + 4 * fq;
#pragma unroll
        for (int ai = 0; ai < 2; ++ai)
#pragma unroll
            for (int m = 0; m < 4; ++m) {
                const int row = u.pm * BM + ai * HALF + wr * 64 + m * 16 + fr;
                float* d = xrow_ptr(R, row);
                if (d) {
                    const float* b = mode == 0 ? xin_ptr(X, row) : d;
#pragma unroll
                    for (int bj = 0; bj < 2; ++bj)
#pragma unroll
                        for (int n = 0; n < 2; ++n) { const int off = col0 + bj * HALF + n * 16; *(f32x4*)(d + off) = *(const f32x4*)(b + off) + acc[ai][bj][m][n]; }
                }
            }
    }
};


struct EpiOut {
    static constexpr bool PERM = false, AFTER_DRAIN = false, MIDK = true;
    RowMap R; XIn X; bf16_t* X1b; const float* ssa; float* ss1;
    __device__ __forceinline__ void mid(f32x4 (&acc)[2][2][4][2], const Unit& u, int wr, int wc, int fr, int fq) const {
#pragma unroll
        for (int ai = 0; ai < 2; ++ai)
#pragma unroll
            for (int m = 0; m < 4; ++m) {
                const int row = u.pm * BM + ai * HALF + wr * 64 + m * 16 + fr;
                const float f = row < MROWS ? 1.0f / sqrtf(ssa[row] * (1.0f / DATT) + EPS) : 0.f;
#pragma unroll
                for (int bj = 0; bj < 2; ++bj)
#pragma unroll
                    for (int n = 0; n < 2; ++n) acc[ai][bj][m][n] *= f;
            }
    }
    __device__ __forceinline__ void operator()(const f32x4 (&acc)[2][2][4][2], const Unit& u, int wr, int wc, int fr, int fq) const {
        const int col0 = u.pn * BM + wc * 32 + 4 * fq;
#pragma unroll
        for (int ai = 0; ai < 2; ++ai)
#pragma unroll
            for (int m = 0; m < 4; ++m) {
                const int row = u.pm * BM + ai * HALF + wr * 64 + m * 16 + fr;
                float* d = xrow_ptr(R, row);
                if (d) {
                    const float* b = xin_ptr(X, row);
                    bf16_t* xb = X1b + (size_t)row * D;
                    float ss = 0.f;
#pragma unroll
                    for (int bj = 0; bj < 2; ++bj)
#pragma unroll
                        for (int n = 0; n < 2; ++n) { const int off = col0 + bj * HALF + n * 16; const f32x4 v = *(const f32x4*)(b + off) + acc[ai][bj][m][n];
                            *(f32x4*)(d + off) = v; *(u32x2*)(xb + off) = (u32x2){cvt_pk_bf16(v[0], v[1]), cvt_pk_bf16(v[2], v[3])};
                            ss += (v[0] * v[0] + v[1] * v[1]) + (v[2] * v[2] + v[3] * v[3]); }
                    ss += swz_xor<16>(ss); ss = sum_x32(ss);
                    if (fq == 0) atomicAdd(ss1 + row, ss);
                }
            }
    }
};

struct EpiUG {
    static constexpr bool PERM = true, AFTER_DRAIN = false, MIDK = false;
    unsigned char* ws; size_t o_act, o_ss1, o_halo, o_first; const float* cw; const float* cb; const float* st; float* out_sfc;
    __device__ __forceinline__ void operator()(const f32x4 (&acc)[2][2][4][2], const Unit& u, int wr, int wc, int fr, int fq) const {
        bf16_t* ACT = (bf16_t*)(ws + o_act); const float* rs1 = (const float*)(ws + o_ss1); float* halo = (float*)(ws + o_halo); float* first = (float*)(ws + o_first);
        const int lane = (fq << 4) | fr;
        const int ch0 = u.pn * 128 + wc * 32 + 8 * fq;
        float w0[8], w1[8], w2[8], b0[8];
#pragma unroll
        for (int h = 0; h < 2; ++h) {
            const f32x4 a = *(const f32x4*)(cw + ch0 + 4 * h), b = *(const f32x4*)(cw + DFF + ch0 + 4 * h), c = *(const f32x4*)(cw + 2 * DFF + ch0 + 4 * h), d = *(const f32x4*)(cb + ch0 + 4 * h);
#pragma unroll
            for (int j = 0; j < 4; ++j) { w0[4 * h + j] = a[j]; w1[4 * h + j] = b[j]; w2[4 * h + j] = c[j]; b0[4 * h + j] = d[j]; }
        }
        const int src1 = (lane & 48) | ((fr + 15) & 15), src2 = (lane & 48) | ((fr + 14) & 15);
#pragma unroll
        for (int ai = 0; ai < 2; ++ai) {
            float pu[8];
#pragma unroll
            for (int e = 0; e < 8; ++e) pu[e] = 0.f;
#pragma unroll
            for (int m = 0; m < 4; ++m) {
                const int R0 = u.pm * BM + ai * HALF + wr * 64 + m * 16, row = R0 + fr;
                if (R0 >= MROWS) continue;
                const float rs = 1.0f / sqrtf(rs1[row] * (1.0f / D) + EPS);
                float uu[8], gg[8];
#pragma unroll
                for (int n = 0; n < 2; ++n)
#pragma unroll
                    for (int j = 0; j < 4; ++j) { uu[4 * n + j] = acc[ai][0][m][n][j] * rs; gg[4 * n + j] = acc[ai][1][m][n][j] * rs; }
                if (R0 < NBIG) {
                    float act[8];
#pragma unroll
                    for (int e = 0; e < 8; ++e) {
                        const float c1 = __shfl(uu[e], src1), c2 = __shfl(uu[e], src2), p1 = __shfl(pu[e], src1), p2 = __shfl(pu[e], src2);
                        const float um1 = fr >= 1 ? c1 : p1, um2 = fr >= 2 ? c2 : p2;
                        act[e] = gelu_tanh(b0[e] + w0[e] * um2 + w1[e] * um1 + w2[e] * uu[e]) * gg[e];
                    }
                    const int q = R0 >> 6;
                    if (m == 0 && fr < 2) {
                        float* f = first + ((size_t)(q * 2 + fr) * 2) * DFF + ch0;
                        *(f32x4*)(f) = (f32x4){uu[0], uu[1], uu[2], uu[3]}; *(f32x4*)(f + 4) = (f32x4){uu[4], uu[5], uu[6], uu[7]};
                        *(f32x4*)(f + DFF) = (f32x4){gg[0], gg[1], gg[2], gg[3]}; *(f32x4*)(f + DFF + 4) = (f32x4){gg[4], gg[5], gg[6], gg[7]};
                    } else {
                        u32x4 w; w.x = cvt_pk_bf16(act[0], act[1]); w.y = cvt_pk_bf16(act[2], act[3]); w.z = cvt_pk_bf16(act[4], act[5]); w.w = cvt_pk_bf16(act[6], act[7]);
                        *(u32x4*)(ACT + (size_t)row * DFF + ch0) = w;
                    }
                    if (m == 3 && fr >= 14) {
                        float* f = halo + ((size_t)q * 2 + (fr - 14)) * DFF + ch0;
                        *(f32x4*)(f) = (f32x4){uu[0], uu[1], uu[2], uu[3]}; *(f32x4*)(f + 4) = (f32x4){uu[4], uu[5], uu[6], uu[7]};
                    }
#pragma unroll
                    for (int e = 0; e < 8; ++e) pu[e] = uu[e];
                } else if (R0 == ROW_META) {
                    if (fr >= 14) {
                        float* f = halo + ((size_t)128 * 2 + (fr - 14)) * DFF + ch0;
                        *(f32x4*)(f) = (f32x4){uu[0], uu[1], uu[2], uu[3]}; *(f32x4*)(f + 4) = (f32x4){uu[4], uu[5], uu[6], uu[7]};
                    }
                } else {
                    const int b = row - ROW_SAMP;
                    const float* s0p = st + ((size_t)b * 2) * DFF + ch0; const float* s1p = s0p + DFF;
                    const f32x4 s0a = *(const f32x4*)s0p, s0b = *(const f32x4*)(s0p + 4), s1a = *(const f32x4*)s1p, s1b = *(const f32x4*)(s1p + 4);
                    float act[8];
#pragma unroll
                    for (int e = 0; e < 8; ++e) {
                        const float h0 = e < 4 ? s0a[e & 3] : s0b[e & 3], h1 = e < 4 ? s1a[e & 3] : s1b[e & 3];
                        act[e] = gelu_tanh(b0[e] + w0[e] * h0 + w1[e] * h1 + w2[e] * uu[e]) * gg[e];
                    }
                    u32x4 w; w.x = cvt_pk_bf16(act[0], act[1]); w.y = cvt_pk_bf16(act[2], act[3]); w.z = cvt_pk_bf16(act[4], act[5]); w.w = cvt_pk_bf16(act[6], act[7]);
                    *(u32x4*)(ACT + (size_t)row * DFF + ch0) = w;
                    float* o = out_sfc + ((size_t)b * 2) * DFF + ch0;
                    *(f32x4*)(o) = s1a; *(f32x4*)(o + 4) = s1b;
                    *(f32x4*)(o + DFF) = (f32x4){uu[0], uu[1], uu[2], uu[3]}; *(f32x4*)(o + DFF + 4) = (f32x4){uu[4], uu[5], uu[6], uu[7]};
                }
            }
        }
    }
};

template <class Epi, class Sched, bool ALIGN_EPI = false, bool SP2 = false>
__device__ __forceinline__ void gemm_phase(PG8_LAS unsigned char* lds, const Gemm g, const Sched& S, const Epi& E, int tid_in) {
    int tid_ = tid_in; asm volatile("" : "+v"(tid_));
    const int tid = tid_, wid = __builtin_amdgcn_readfirstlane(tid >> 6), lane = tid & 63, wr = wid >> 2, wc = wid & 3, fr = lane & 15, fq = lane >> 4;
    const int K = g.K, nt = K / BK;
    unsigned voffA[2], voffB[2];
#pragma unroll
    for (int i = 0; i < 2; ++i) { int R, C; stage_rc(tid * 16 + i * 8192, R, C); const int Rb = Epi::PERM ? ((R & ~31) + perm32(R & 31)) : R;
        voffA[i] = (unsigned)(R * K + C) * 2u; voffB[i] = (unsigned)(Rb * K + C) * 2u; }
    const size_t kstep = (size_t)(BK * 2);
    const size_t hstep = (size_t)HALF * K * 2;
    const size_t tstep = 2 * hstep;
    const unsigned ldsw = (unsigned)wid * 1024u;
    const int aoff = lds_byte(wr * 64 + fr, fq * 8), boff = lds_byte(wc * 32 + fr, fq * 8);
#define PG8_SA(b, h) (((b) * 2 + (h)) * HTB)
#define PG8_SB(b, h) ((4 + (b) * 2 + (h)) * HTB)
#define PG8_STAGE(bufoff, gbase, voff) do { _Pragma("unroll") for (int _i = 0; _i < 2; ++_i) \
        __builtin_amdgcn_global_load_lds((const unsigned*)((const char*)(gbase) + (voff)[_i]), (PG8_LAS unsigned*)(lds + (bufoff) + ldsw + _i * 8192), 16, 0, 0); } while (0)
#define PG8_LDA(dst, b, h) do { _Pragma("unroll") for (int m = 0; m < 4; ++m) _Pragma("unroll") for (int k = 0; k < 2; ++k) dst[m][k] = *(const PG8_LAS bf16x8*)(lds + PG8_SA(b, h) + aoff + m * 2048 + k * 1024); } while (0)
#define PG8_LDB(dst, b, h) do { _Pragma("unroll") for (int n = 0; n < 2; ++n) _Pragma("unroll") for (int k = 0; k < 2; ++k) dst[n][k] = *(const PG8_LAS bf16x8*)(lds + PG8_SB(b, h) + boff + n * 2048 + k * 1024); } while (0)
#define PG8_MMA(ai, bj, At, Bt) do { __builtin_amdgcn_s_setprio(1); _Pragma("unroll") for (int m = 0; m < 4; ++m) _Pragma("unroll") for (int n = 0; n < 2; ++n) _Pragma("unroll") for (int k = 0; k < 2; ++k) \
        acc[ai][bj][m][n] = __builtin_amdgcn_mfma_f32_16x16x32_bf16(Bt[n][k], At[m][k], acc[ai][bj][m][n], 0, 0, 0); __builtin_amdgcn_s_setprio(0); } while (0)
#define PG8_WAIT_V(n) asm volatile("s_waitcnt vmcnt(" #n ")" ::: "memory")
#define PG8_WAIT_L(n) asm volatile("s_waitcnt lgkmcnt(" #n ")" ::: "memory")
#define PG8_BAR __builtin_amdgcn_s_barrier()
#define PG8_SCHED __builtin_amdgcn_sched_barrier(0)
    Unit cur, nxt; int ui = 0;
    if (!S.next(0, cur)) return;
    f32x4 acc[2][2][4][2];
#pragma unroll
    for (int a = 0; a < 2; ++a)
#pragma unroll
        for (int b = 0; b < 2; ++b)
#pragma unroll
            for (int m = 0; m < 4; ++m)
#pragma unroll
                for (int n = 0; n < 2; ++n) acc[a][b][m][n] = (f32x4){0.f, 0.f, 0.f, 0.f};
    bf16x8 At[4][2], B0[2][2], B1[2][2];
    const char* cA = (const char*)g.A + (size_t)cur.pm * tstep; const char* cB = (const char*)g.Bt + (size_t)cur.pn * tstep;
    S.a_ready(cur);
    if constexpr (SP2) {
        PG8_STAGE(PG8_SB(0, 0), cB, voffB); PG8_STAGE(PG8_SB(0, 1), cB + hstep, voffB); PG8_STAGE(PG8_SA(0, 0), cA, voffA); PG8_STAGE(PG8_SA(0, 1), cA + hstep, voffA);
        if (wr == 1) PG8_BAR;
        PG8_WAIT_V(2); PG8_BAR;
        PG8_STAGE(PG8_SB(1, 0), cB + kstep, voffB); PG8_STAGE(PG8_SA(1, 0), cA + kstep, voffA); PG8_STAGE(PG8_SB(1, 1), cB + hstep + kstep, voffB);
        PG8_WAIT_V(6); PG8_BAR;
    } else {
        PG8_STAGE(PG8_SB(0, 0), cB, voffB); PG8_STAGE(PG8_SA(0, 0), cA, voffA); PG8_STAGE(PG8_SB(0, 1), cB + hstep, voffB); PG8_STAGE(PG8_SA(0, 1), cA + hstep, voffA);
        if (wr == 1) PG8_BAR;
        PG8_WAIT_V(4); PG8_BAR;
        PG8_STAGE(PG8_SB(1, 0), cB + kstep, voffB); PG8_STAGE(PG8_SA(1, 0), cA + kstep, voffA); PG8_STAGE(PG8_SB(1, 1), cB + hstep + kstep, voffB);
        PG8_WAIT_V(6); PG8_BAR;
    }
    for (;;) {
        const bool has_next = S.next(ui + 1, nxt);
        const char* nA = has_next ? (const char*)g.A + (size_t)nxt.pm * tstep : cA; const char* nB = has_next ? (const char*)g.Bt + (size_t)nxt.pn * tstep : cB;
        for (int t = 0; t < nt; t += 2) {
            const bool last = (t == nt - 2);
            const char* a1 = cA + (size_t)(t + 1) * kstep;
            const char* a2 = last ? nA : cA + (size_t)(t + 2) * kstep; const char* b2 = last ? nB : cB + (size_t)(t + 2) * kstep;
            const char* a3 = a2 + kstep; const char* b3 = b2 + kstep;
            if (last && has_next) S.a_ready(nxt);
            if constexpr (SP2) {
            PG8_LDB(B0, 0, 0); PG8_LDB(B1, 0, 1); PG8_SCHED; PG8_LDA(At, 0, 0); PG8_STAGE(PG8_SA(1, 1), a1 + hstep, voffA);
            PG8_WAIT_V(8); PG8_WAIT_L(0); PG8_BAR; PG8_MMA(0, 0, At, B0); PG8_MMA(0, 1, At, B1); PG8_BAR; PG8_SCHED;
            PG8_LDA(At, 0, 1); PG8_STAGE(PG8_SB(0, 0), b2, voffB); PG8_STAGE(PG8_SB(0, 1), b2 + hstep, voffB); PG8_STAGE(PG8_SA(0, 0), a2, voffA);
            PG8_WAIT_V(8); PG8_WAIT_L(0); PG8_BAR; PG8_MMA(1, 0, At, B0); PG8_MMA(1, 1, At, B1); PG8_BAR; PG8_SCHED;
            PG8_LDB(B0, 1, 0); PG8_LDB(B1, 1, 1); PG8_SCHED; PG8_LDA(At, 1, 0); PG8_STAGE(PG8_SA(0, 1), a2 + hstep, voffA);
            PG8_WAIT_V(8); PG8_WAIT_L(0); PG8_BAR; PG8_MMA(0, 0, At, B0); PG8_MMA(0, 1, At, B1); PG8_BAR; PG8_SCHED;
            PG8_LDA(At, 1, 1); PG8_STAGE(PG8_SB(1, 0), b3, voffB); PG8_STAGE(PG8_SB(1, 1), b3 + hstep, voffB); PG8_STAGE(PG8_SA(1, 0), a3, voffA);
            PG8_WAIT_V(8); PG8_WAIT_L(0); PG8_BAR; PG8_MMA(1, 0, At, B0); PG8_MMA(1, 1, At, B1); PG8_BAR; PG8_SCHED;
            } else {
            PG8_LDB(B0, 0, 0); PG8_SCHED; PG8_LDA(At, 0, 0); PG8_STAGE(PG8_SA(1, 1), a1 + hstep, voffA);
            PG8_WAIT_L(8); PG8_BAR; PG8_WAIT_L(0); PG8_MMA(0, 0, At, B0); PG8_BAR; PG8_SCHED;
            PG8_LDB(B1, 0, 1); PG8_STAGE(PG8_SB(0, 0), b2, voffB);
            PG8_BAR; PG8_WAIT_L(0); PG8_MMA(0, 1, At, B1); PG8_BAR;
            PG8_LDA(At, 0, 1); PG8_STAGE(PG8_SA(0, 0), a2, voffA);
            PG8_BAR; PG8_WAIT_L(0); PG8_MMA(1, 0, At, B0); PG8_BAR; PG8_SCHED;
            PG8_STAGE(PG8_SB(0, 1), b2 + hstep, voffB);
            PG8_WAIT_V(6); PG8_BAR; PG8_MMA(1, 1, At, B1); PG8_BAR;
            PG8_LDB(B0, 1, 0); PG8_SCHED; PG8_LDA(At, 1, 0); PG8_STAGE(PG8_SA(0, 1), a2 + hstep, voffA);
            PG8_WAIT_L(8); PG8_BAR; PG8_WAIT_L(0); PG8_MMA(0, 0, At, B0); PG8_BAR; PG8_SCHED;
            PG8_LDB(B1, 1, 1); PG8_STAGE(PG8_SB(1, 0), b3, voffB);
            PG8_BAR; PG8_WAIT_L(0); PG8_MMA(0, 1, At, B1); PG8_BAR;
            PG8_LDA(At, 1, 1); PG8_STAGE(PG8_SA(1, 0), a3, voffA);
            PG8_BAR; PG8_WAIT_L(0); PG8_MMA(1, 0, At, B0); PG8_BAR; PG8_SCHED;
            PG8_STAGE(PG8_SB(1, 1), b3 + hstep, voffB);
            PG8_WAIT_V(6); PG8_BAR; PG8_MMA(1, 1, At, B1); PG8_BAR;
            }
            if constexpr (Epi::MIDK) { if (t + 2 == (nt >> 1)) E.mid(acc, cur, wr, wc, fr, fq); }
        }
        if constexpr (ALIGN_EPI) { if (wr == 0) PG8_BAR; }
        if constexpr (!Epi::AFTER_DRAIN) { E(acc, cur, wr, wc, fr, fq); S.done(cur); }
        if (!has_next) break;
#pragma unroll
        for (int a = 0; a < 2; ++a)
#pragma unroll
            for (int b = 0; b < 2; ++b)
#pragma unroll
                for (int m = 0; m < 4; ++m)
#pragma unroll
                    for (int n = 0; n < 2; ++n) acc[a][b][m][n] = (f32x4){0.f, 0.f, 0.f, 0.f};
        cur = nxt; cA = nA; cB = nB; ++ui;
        if constexpr (ALIGN_EPI) { if (wr == 1) PG8_BAR; }
    }
    PG8_WAIT_V(0);
    if constexpr (!ALIGN_EPI) { if (wr == 0) PG8_BAR; }
    PG8_BAR;
    if constexpr (Epi::AFTER_DRAIN) { E.fused(acc, cur, wr, wc, fr, fq, lds, wid, lane); S.done(cur); }
#undef PG8_SA
#undef PG8_SB
#undef PG8_STAGE
#undef PG8_LDA
#undef PG8_LDB
#undef PG8_MMA
#undef PG8_WAIT_V
#undef PG8_WAIT_L
#undef PG8_BAR
#undef PG8_SCHED
}
}

using pg8::Gemm;
__device__ __forceinline__ int fresh_lane() { int l; asm volatile("v_mbcnt_lo_u32_b32 %0, -1, 0\n\tv_mbcnt_hi_u32_b32 %0, -1, %0" : "=v"(l)); return l; }
#define LAS __attribute__((address_space(3)))

constexpr size_t MiB = 1u << 20;
constexpr size_t WS_CTL = 0;
constexpr size_t WS_WIN = 1 * MiB;
constexpr size_t WS_WOUT = WS_WIN + (size_t)DIN * D * 2;
constexpr size_t WS_WUG = WS_WOUT + (size_t)D * D * 2;
constexpr size_t WS_WDN = WS_WUG + (size_t)2 * DFF * D * 2;
constexpr size_t WS_R1 = WS_WDN + (size_t)D * DFF * 2;
constexpr size_t WS_H0 = WS_R1;
constexpr size_t WS_Z = WS_H0 + (size_t)MP * D * 2;
constexpr size_t WS_MIX = WS_Z + (size_t)MP * DIN * 2;
constexpr size_t WS_ACT = WS_R1;
constexpr size_t WS_R1_END = WS_MIX + (size_t)MP * D * 2;
constexpr size_t WS_X1B = WS_R1_END;
constexpr size_t WS_XS = WS_X1B + (size_t)MP * D * 2;
constexpr size_t WS_SSA = WS_XS + (size_t)64 * D * 4;
constexpr size_t WS_RS1 = WS_SSA + (size_t)MP * 4;
constexpr size_t WS_HALO = WS_RS1 + (size_t)MP * 4;
constexpr size_t WS_FIRST = WS_HALO + (size_t)129 * 2 * DFF * 4;
constexpr size_t WS_END = WS_FIRST + (size_t)128 * 4 * DFF * 4;
constexpr size_t WS_GWF = WS_FIRST;
constexpr size_t WS_SUMA = WS_GWF + (size_t)16384 * 16;
constexpr size_t WS_SUMB = WS_SUMA + (size_t)65 * 1024 * 4;
constexpr size_t WS_SUMHA = WS_SUMB + (size_t)65 * 1024 * 4;
constexpr size_t WS_SUMHB = WS_SUMHA + (size_t)129 * 1024 * 4;
static_assert(WS_SUMHB + (size_t)129 * 1024 * 4 <= WS_END, "scan scratch fits inside first[]");
static_assert(WS_ACT + (size_t)MP * DFF * 2 <= WS_R1_END, "ACT overlay fits in H0|Z|MIX");
static_assert(WS_END <= 308053024, "workspace map must fit the guaranteed d_ws size");


namespace cg = cooperative_groups;
struct Params {
    const float *x_prompt, *x_sample, *st_conv, *st_h, *cache_k, *cache_v, *st_ffn, *meta, *table, *norm_mix, *w_in, *conv_w, *conv_b, *ga_w, *ga_b, *gx_w, *gx_b, *lam, *sinks,
                *norm_rnn, *norm_attn, *w_out, *norm_ffn, *w_up, *w_gate, *fconv_w, *fconv_b, *w_down, *norm_final;
    float* out; unsigned char* ws;
};
__device__ __forceinline__ void prep_row(const XIn& X, bf16_t* H0, int row, int lane) {
    u32x2* o = (u32x2*)(H0 + (size_t)row * D) + lane;
    const float* src = xin_ptr(X, row);
    if (!src) {
#pragma unroll
        for (int j = 0; j < 8; ++j) o[64 * j] = (u32x2){0u, 0u};
        return;
    }
    const f32x4* xr = (const f32x4*)src + lane;
    f32x4 v[8]; float s = 0.f;
#pragma unroll
    for (int j = 0; j < 8; ++j) { v[j] = xr[64 * j]; s += (v[j].x * v[j].x + v[j].y * v[j].y) + (v[j].z * v[j].z + v[j].w * v[j].w); }
    const float rs = 1.0f / sqrtf(wave_sum(s) * (1.0f / D) + EPS);
#pragma unroll
    for (int j = 0; j < 8; ++j) o[64 * j] = (u32x2){pk2(v[j].x * rs, v[j].y * rs), pk2(v[j].z * rs, v[j].w * rs)};
}
__device__ __forceinline__ void mixnorm_row(const RowMap& R, bf16_t* MIX, int row, int lane) {
    const f32x4* y = (const f32x4*)xrow_ptr(R, row) + lane;
    f32x4 v[8]; float s0 = 0.f, s1 = 0.f;
#pragma unroll
    for (int j = 0; j < 8; ++j) { v[j] = y[64 * j]; const float q = (v[j].x * v[j].x + v[j].y * v[j].y) + (v[j].z * v[j].z + v[j].w * v[j].w); if (j < 4) s0 += q; else s1 += q; }
    const float r0 = 1.0f / sqrtf(wave_sum(s0) * (1.0f / DRNN) + EPS), r1 = 1.0f / sqrtf(wave_sum(s1) * (1.0f / DATT) + EPS);
    u32x2* o = (u32x2*)(MIX + (size_t)row * D) + lane;
#pragma unroll
    for (int j = 0; j < 8; ++j) { const float r = j < 4 ? r0 : r1; o[64 * j] = (u32x2){pk2(v[j].x * r, v[j].y * r), pk2(v[j].z * r, v[j].w * r)}; }
}
__device__ __forceinline__ void x1b_row(const RowMap& R, bf16_t* X1b, float* rs1, int row, int lane) {
    const f32x4* y = (const f32x4*)xrow_ptr(R, row) + lane;
    f32x4 v[8]; float s = 0.f;
#pragma unroll
    for (int j = 0; j < 8; ++j) { v[j] = y[64 * j]; s += (v[j].x * v[j].x + v[j].y * v[j].y) + (v[j].z * v[j].z + v[j].w * v[j].w); }
    s = wave_sum(s);
    if (lane == 0) rs1[row] = 1.0f / sqrtf(s * (1.0f / D) + EPS);
    u32x2* o = (u32x2*)(X1b + (size_t)row * D) + lane;
#pragma unroll
    for (int j = 0; j < 8; ++j) o[64 * j] = (u32x2){pk2(v[j].x, v[j].y), pk2(v[j].z, v[j].w)};
}
__device__ __forceinline__ void final_row(float* out, const float* gfin, int r, int lane) {
    f32x4* y = (f32x4*)(out + (r < NBIG ? O_Y + (size_t)r * D : O_YS + (size_t)(r - NBIG) * D)) + lane;
    const f32x4* g = (const f32x4*)gfin + lane;
    f32x4 v[8]; float s = 0.f;
#pragma unroll
    for (int j = 0; j < 8; ++j) { v[j] = y[64 * j]; s += (v[j].x * v[j].x + v[j].y * v[j].y) + (v[j].z * v[j].z + v[j].w * v[j].w); }
    const float rs = 1.0f / sqrtf(wave_sum(s) * (1.0f / D) + EPS);
#pragma unroll
    for (int j = 0; j < 8; ++j) y[64 * j] = v[j] * rs * g[64 * j];
}
struct WPrep { const float *w_in, *w_out, *w_up, *w_gate, *w_down, *g_mix, *g_rnn, *g_attn, *g_ffn; bf16_t *t_in, *t_out, *t_ug, *t_dn; };
constexpr int WT_IN = (D / 64) * (DIN / 64), WT_OUT = (D / 64) * (D / 64), WT_UP = (D / 64) * (DFF / 64), WT_DN = (DFF / 64) * (D / 64);
constexpr int WT_TOTAL = WT_IN + WT_OUT + 2 * WT_UP + WT_DN;
static_assert(WT_TOTAL % 2 == 0, "two tiles per block iteration");
struct WTile { const float* src; bf16_t* dst; int N, K, job, k0, n0; };
__device__ __forceinline__ WTile wprep_decode(const WPrep& P, int it) {
    WTile t;
    if (it < WT_IN) { t.job = 0; t.src = P.w_in; t.dst = P.t_in; t.K = D; t.N = DIN; }
    else if ((it -= WT_IN) < WT_OUT) { t.job = 1; t.src = P.w_out; t.dst = P.t_out; t.K = D; t.N = D; }
    else if ((it -= WT_OUT) < WT_UP) { t.job = 2; t.src = P.w_up; t.dst = P.t_ug; t.K = D; t.N = DFF; }
    else if ((it -= WT_UP) < WT_UP) { t.job = 3; t.src = P.w_gate; t.dst = P.t_ug; t.K = D; t.N = DFF; }
    else { it -= WT_UP; t.job = 4; t.src = P.w_down; t.dst = P.t_dn; t.K = DFF; t.N = D; }
    const int nblk = t.N / 64; t.k0 = (it / nblk) * 64; t.n0 = (it % nblk) * 64;
    return t;
}
__device__ __forceinline__ void wprep_load(const WTile& t, int tid, f32x4 (&v)[4]) {
    const float* p = t.src + (size_t)(t.k0 + (tid >> 4)) * t.N + t.n0 + 4 * (tid & 15);
#pragma unroll
    for (int i = 0; i < 4; ++i) v[i] = *(const f32x4*)(p + (size_t)(16 * i) * t.N);
}
__device__ __forceinline__ void wprep_store(const WPrep& P, const WTile& t, int tid, const f32x4 (&v)[4], LAS float* s  ) {
#pragma unroll
    for (int i = 0; i < 4; ++i) {
        const int kk = (tid >> 4) + 16 * i, k = t.k0 + kk;
        float g = 1.0f;
        if (t.job == 0) g = P.g_mix[k]; else if (t.job == 1) g = k < DRNN ? P.g_rnn[k] : P.g_attn[k - DRNN]; else if (t.job == 2 || t.job == 3) g = P.g_ffn[k];
        LAS float* sp = s + kk * 65 + 4 * (tid & 15);
        sp[0] = v[i].x * g; sp[1] = v[i].y * g; sp[2] = v[i].z * g; sp[3] = v[i].w * g;
    }
    __syncthreads();
#pragma unroll
    for (int h = 0; h < 2; ++h) {
        const int n = tid >> 2, c = (tid & 3) + 4 * h, ng = t.n0 + n;
        int drow = ng;
        if (t.job == 2) drow = 256 * (ng >> 7) + (ng & 127); else if (t.job == 3) drow = 256 * (ng >> 7) + 128 + (ng & 127);
        const LAS float* sp = s + (8 * c) * 65 + n;
        u32x4 o; o.x = pk2(sp[0], sp[65]); o.y = pk2(sp[2 * 65], sp[3 * 65]); o.z = pk2(sp[4 * 65], sp[5 * 65]); o.w = pk2(sp[6 * 65], sp[7 * 65]);
        const int kd = t.job == 1 ? ((t.k0 + DRNN) & (D - 1)) : t.k0;
        *(u32x4*)(t.dst + (size_t)drow * t.K + kd + 8 * c) = o;
    }
    __syncthreads();
}
__device__ __forceinline__ int rel_bucket(int d) {
    if (d < 16) return d;
    const int l = 16 + (int)(logf((float)d * (1.0f / 16.0f)) / 2.0794415417f * 16.0f);
    return l < 31 ? l : 31;
}

typedef short bf16x8 __attribute__((ext_vector_type(8)));
typedef float f32x16 __attribute__((ext_vector_type(16)));
constexpr int NCHUNK = 65;
struct ScanIn {
    const bf16_t* Z; RowMap R; bf16_t* MIX;
    const float *st_conv, *st_h, *conv_w, *conv_b, *ga_b, *gx_b, *lam;
    const u32x4* gwf;
    float *sumA, *sumB;
    float *sumHA, *sumHB;
    bf16_t *oma, *bb;
    float* out;
};
__device__ __forceinline__ void prep_gwf_frag(const float* ga_w, const float* gx_w, u32x4* gwf, int i) {
    const int lane = i & 63, s = (i >> 6) & 3, nb = (i >> 8) & 1, gate = (i >> 9) & 1, blk = i >> 10;
    const float* W = (gate ? gx_w : ga_w) + (size_t)blk * 64 * 64;
    const int n = 32 * nb + (lane & 31), k0 = 16 * s + 8 * (lane >> 5);
    u32x4 o; o.x = pk2(W[(k0 + 0) * 64 + n], W[(k0 + 1) * 64 + n]); o.y = pk2(W[(k0 + 2) * 64 + n], W[(k0 + 3) * 64 + n]);
    o.z = pk2(W[(k0 + 4) * 64 + n], W[(k0 + 5) * 64 + n]); o.w = pk2(W[(k0 + 6) * 64 + n], W[(k0 + 7) * 64 + n]);
    gwf[i] = o;
}
__device__ __forceinline__ float bflo(unsigned w) { return __uint_as_float(w << 16); }
__device__ __forceinline__ float bfhi(unsigned w) { return __uint_as_float(w & 0xffff0000u); }

template <int MODE>
__device__ __forceinline__ void gate_preact(const ScanIn& S, int blk, int t0, int b0, int lane, f32x16& pa0, f32x16& pa1, f32x16& px0, f32x16& px1) {
    const int tt = lane & 31, hh = lane >> 5;
    f32x16 aa0 = {}, aa1 = {}, ax0 = {}, ax1 = {};
#pragma unroll 1
    for (int s = 0; s < 4; ++s) {
        const int ch = 64 * blk + 16 * s + 8 * hh;
        float xc[8];
        { const f32x4 c0 = *(const f32x4*)(S.conv_b + ch), c1 = *(const f32x4*)(S.conv_b + ch + 4);
#pragma unroll
          for (int e = 0; e < 4; ++e) { xc[e] = c0[e]; xc[4 + e] = c1[e]; } }
#pragma unroll
        for (int j = 0; j < 4; ++j) {
            const f32x4 w0 = *(const f32x4*)(S.conv_w + j * DRNN + ch), w1 = *(const f32x4*)(S.conv_w + j * DRNN + ch + 4);
            float xv[8];
            if (MODE == 2 && j < 3) {
                const float* sp = S.st_conv + ((size_t)(b0 + tt) * 3 + j) * DRNN + ch;
                const f32x4 a = *(const f32x4*)sp, b = *(const f32x4*)(sp + 4);
#pragma unroll
                for (int e = 0; e < 4; ++e) { xv[e] = a[e]; xv[4 + e] = b[e]; }
            } else {
                const int t = t0 + tt - 3 + j;
                const int row = MODE == 2 ? ROW_SAMP + b0 + tt : tok2row(t < 0 ? 0 : t);
                u32x4 q = *(const u32x4*)(S.Z + (size_t)row * DIN + ZC_XR + ch);
                if (MODE != 2 && t < 0) q = (u32x4){0u, 0u, 0u, 0u};
                xv[0] = bflo(q.x); xv[1] = bfhi(q.x); xv[2] = bflo(q.y); xv[3] = bfhi(q.y); xv[4] = bflo(q.z); xv[5] = bfhi(q.z); xv[6] = bflo(q.w); xv[7] = bfhi(q.w);
            }
#pragma unroll
            for (int e = 0; e < 4; ++e) { xc[e] += w0[e] * xv[e]; xc[4 + e] += w1[e] * xv[4 + e]; }
        }
        u32x4 ap; ap.x = pk2(xc[0], xc[1]); ap.y = pk2(xc[2], xc[3]); ap.z = pk2(xc[4], xc[5]); ap.w = pk2(xc[6], xc[7]);
        const bf16x8 A = __builtin_bit_cast(bf16x8, ap);
        const u32x4* g = S.gwf + ((size_t)(blk * 2) * 2 * 4 + s) * 64 + lane;
        const bf16x8 Ba0 = __builtin_bit_cast(bf16x8, g[0]), Ba1 = __builtin_bit_cast(bf16x8, g[4 * 64]), Bx0 = __builtin_bit_cast(bf16x8, g[8 * 64]), Bx1 = __builtin_bit_cast(bf16x8, g[12 * 64]);
        aa0 = __builtin_amdgcn_mfma_f32_32x32x16_bf16(A, Ba0, aa0, 0, 0, 0);
        aa1 = __builtin_amdgcn_mfma_f32_32x32x16_bf16(A, Ba1, aa1, 0, 0, 0);
        ax0 = __builtin_amdgcn_mfma_f32_32x32x16_bf16(A, Bx0, ax0, 0, 0, 0);
        ax1 = __builtin_amdgcn_mfma_f32_32x32x16_bf16(A, Bx1, ax1, 0, 0, 0);
    }
#pragma unroll
    for (int i = 0; i < 16; ++i) {
        auto r = __builtin_amdgcn_permlane32_swap(__float_as_uint(aa0[i]), __float_as_uint(aa1[i]), false, false);
        pa0[i] = __uint_as_float(r[0]); pa1[i] = __uint_as_float(r[1]);
        auto q = __builtin_amdgcn_permlane32_swap(__float_as_uint(ax0[i]), __float_as_uint(ax1[i]), false, false);
        px0[i] = __uint_as_float(q[0]); px1[i] = __uint_as_float(q[1]);
    }
}

struct ChanConst { float cw0, cw1, cw2, cw3, cb, ba, bx, csp; };
__device__ __forceinline__ ChanConst chan_const(const ScanIn& S, int c) {
    ChanConst k; k.cw0 = S.conv_w[c]; k.cw1 = S.conv_w[DRNN + c]; k.cw2 = S.conv_w[2 * DRNN + c]; k.cw3 = S.conv_w[3 * DRNN + c]; k.cb = S.conv_b[c];
    k.ba = S.ga_b[c]; k.bx = S.gx_b[c];
    const float lam = S.lam[c];
    k.csp = 8.0f * (fmaxf(-lam, 0.f) + log1pf(expf(-fabsf(lam))));
    return k;
}
__device__ __forceinline__ void lru_ab(const ChanConst& k, float pa, float px, float xc, float& oma, float& b) {
    const float r = sigmoid_f(pa + k.ba), ig = sigmoid_f(px + k.bx);
    const float a = __builtin_amdgcn_exp2f(k.csp * r * (-1.4426950409f));
    oma = 1.0f - a;
    b = __builtin_amdgcn_sqrtf(oma * (1.0f + a)) * ig * xc;
}
__device__ __forceinline__ void rglru_passA(const ScanIn& S, int k, int hfc, int wave, int lane) {
    const int blk = 8 * hfc + wave, c = 64 * blk + lane;
    const int nsub = k == 0 ? 1 : 4, tbase = k == 0 ? 0 : 16 + 128 * (k - 1), nv = k == 0 ? 16 : 32;
    const ChanConst kc = chan_const(S, c);
    float x3 = tbase - 3 >= 0 ? bf2f(S.Z[(size_t)tok2row(tbase - 3) * DIN + ZC_XR + c]) : 0.f;
    float x2 = tbase - 2 >= 0 ? bf2f(S.Z[(size_t)tok2row(tbase - 2) * DIN + ZC_XR + c]) : 0.f;
    float x1 = tbase - 1 >= 0 ? bf2f(S.Z[(size_t)tok2row(tbase - 1) * DIN + ZC_XR + c]) : 0.f;
    float P = 1.f, hl = 0.f, P0 = 1.f, hl0 = 0.f;
    for (int sc = 0; sc < nsub; ++sc) {
        if (sc == 2) { P0 = P; hl0 = hl; P = 1.f; hl = 0.f; }
        const int t0 = tbase + 32 * sc, row0 = tok2row(t0);
        f32x16 pa0, pa1, px0, px1;
        gate_preact<0>(S, blk, t0, 0, lane, pa0, pa1, px0, px1);
        const bf16_t* zp = S.Z + (size_t)row0 * DIN + ZC_XR + c;
        bf16_t* op = S.oma + (size_t)row0 * DRNN + c; bf16_t* bp = S.bb + (size_t)row0 * DRNN + c;
#pragma unroll
        for (int q = 0; q < 2; ++q) {
            float xr[16];
#pragma unroll
            for (int i = 0; i < 16; ++i) xr[i] = bf2f(zp[(size_t)(16 * q + i) * DIN]);
#pragma unroll
            for (int i = 0; i < 16; ++i) {
                const int tt = 16 * q + i;
                if (tt < nv) {
                    const int g = tt >> 3, hh = (tt >> 2) & 1, j = tt & 3;
                    const float pa = hh ? pa1[4 * g + j] : pa0[4 * g + j], px = hh ? px1[4 * g + j] : px0[4 * g + j];
                    const float xc = kc.cb + kc.cw0 * x3 + kc.cw1 * x2 + kc.cw2 * x1 + kc.cw3 * xr[i];
                    x3 = x2; x2 = x1; x1 = xr[i];
                    float oma, b; lru_ab(kc, pa, px, xc, oma, b);
                    const unsigned ob = f2bf(oma), bbits = f2bf(b);
                    op[(size_t)tt * DRNN] = (bf16_t)ob; bp[(size_t)tt * DRNN] = (bf16_t)bbits;
                    const float ar = 1.0f - __uint_as_float(ob << 16), br = __uint_as_float(bbits << 16);
                    P *= ar; hl = ar * hl + br;
                }
            }
            asm volatile("" ::: "memory");
        }
    }
    if (k == 0) { S.sumHA[c] = P; S.sumHB[c] = hl; S.sumA[c] = P; S.sumB[c] = hl; }
    else {
        const size_t h0 = (size_t)(1 + 2 * (k - 1)) * DRNN + c;
        S.sumHA[h0] = P0; S.sumHB[h0] = hl0; S.sumHA[h0 + DRNN] = P; S.sumHB[h0 + DRNN] = hl;
        S.sumA[(size_t)k * DRNN + c] = P0 * P; S.sumB[(size_t)k * DRNN + c] = P * hl0 + hl;
    }
}
template <class RowOf>
__device__ __forceinline__ void ytile_store(bf16_t* MIX, LAS unsigned char* lds, int wave, int lane, RowOf rowof) {
#pragma unroll
    for (int i = 0; i < 4; ++i) {
        const int tt = 4 * wave + i, row = rowof(tt);
        if (row < 0) continue;
        const LAS f32x4* yp = (const LAS f32x4*)(lds + (size_t)tt * 4096) + lane;
        f32x4 v[4]; float ss = 0.f;
#pragma unroll
        for (int j = 0; j < 4; ++j) { v[j] = yp[64 * j]; ss += (v[j].x * v[j].x + v[j].y * v[j].y) + (v[j].z * v[j].z + v[j].w * v[j].w); }
        const float rs = 1.0f / sqrtf(wave_sum(ss) * (1.0f / DRNN) + EPS);
        u32x2* o = (u32x2*)(MIX + (size_t)row * D + DRNN) + lane;
#pragma unroll
        for (int j = 0; j < 4; ++j) o[64 * j] = (u32x2){pk2(v[j].x * rs, v[j].y * rs), pk2(v[j].z * rs, v[j].w * rs)};
    }
}
__device__ __forceinline__ void rglru_passB(const ScanIn& S, LAS unsigned char* lds, int hidx, int wave, int lane) {
    const int k = hidx == 0 ? 0 : 1 + ((hidx - 1) >> 1), hf = hidx == 0 ? 0 : (hidx - 1) & 1;
    const int nsub = hidx == 0 ? 1 : 2, tf = hidx == 0 ? 0 : 16 + 128 * (k - 1) + 64 * hf, nv = hidx == 0 ? 16 : 32;
    const int c0 = 128 * wave + 2 * lane;
    float h0 = 0.f, h1 = 0.f;
    for (int k0 = 0; k0 < k; k0 += 8) {
        f32x2 A[8], B[8];
#pragma unroll
        for (int u = 0; u < 8; ++u) { const int kk = k0 + u < k ? k0 + u : k - 1; A[u] = *(const f32x2*)(S.sumA + (size_t)kk * DRNN + c0); B[u] = *(const f32x2*)(S.sumB + (size_t)kk * DRNN + c0); }
#pragma unroll
        for (int u = 0; u < 8; ++u) { const bool v = k0 + u < k; h0 = (v ? A[u].x : 1.f) * h0 + (v ? B[u].x : 0.f); h1 = (v ? A[u].y : 1.f) * h1 + (v ? B[u].y : 0.f); }
    }
    if (hf) { const f32x2 A = *(const f32x2*)(S.sumHA + (size_t)(hidx - 1) * DRNN + c0), B = *(const f32x2*)(S.sumHB + (size_t)(hidx - 1) * DRNN + c0); h0 = A.x * h0 + B.x; h1 = A.y * h1 + B.y; }
    for (int s2 = 0; s2 < nsub; ++s2) {
        const int t0 = tf + 32 * s2, row0 = tok2row(t0);
        const bf16_t* op = S.oma + (size_t)row0 * DRNN + c0; const bf16_t* bp = S.bb + (size_t)row0 * DRNN + c0; const bf16_t* gp = S.Z + (size_t)row0 * DIN + ZC_GR + c0;
#pragma unroll
        for (int q = 0; q < 4; ++q) {
            unsigned wo[8], wb[8], wg[8];
#pragma unroll
            for (int i = 0; i < 8; ++i) { const int tt = 8 * q + i; wo[i] = *(const unsigned*)(op + (size_t)tt * DRNN); wb[i] = *(const unsigned*)(bp + (size_t)tt * DRNN); wg[i] = *(const unsigned*)(gp + (size_t)tt * DIN); }
#pragma unroll
            for (int i = 0; i < 8; ++i) {
                const int tt = 8 * q + i;
                if (tt < nv) {
                    h0 = h0 - bflo(wo[i]) * h0 + bflo(wb[i]); h1 = h1 - bfhi(wo[i]) * h1 + bfhi(wb[i]);
                    *(LAS f32x2*)(lds + (size_t)tt * 4096 + c0 * 4) = (f32x2){h0 * gelu_tanh(bflo(wg[i])), h1 * gelu_tanh(bfhi(wg[i]))};
                }
            }
            asm volatile("" ::: "memory");
        }
        __syncthreads();
        ytile_store(S.MIX, lds, wave, lane, [&](int tt) { return tt < nv ? row0 + tt : -1; });
        __syncthreads();
    }
    if (hidx == 128) { const int l2 = fresh_lane(); *(f32x2*)(S.out + O_PRH + 128 * wave + 2 * l2) = (f32x2){h0, h1}; }
}
__device__ __forceinline__ void rglru_sample_out(const ScanIn& S, LAS unsigned char* lds, int sb, int wave, int lane) {
    const int b0 = 32 * sb;
#pragma unroll
    for (int hb = 0; hb < 2; ++hb) {
        const int blk = 2 * wave + hb, c = 64 * blk + lane;
        const ChanConst kc = chan_const(S, c);
        f32x16 pa0, pa1, px0, px1;
        gate_preact<2>(S, blk, 0, b0, lane, pa0, pa1, px0, px1);
        const float* stp = S.st_conv + (size_t)b0 * 3 * DRNN + c; const float* hp = S.st_h + (size_t)b0 * DRNN + c;
        const bf16_t* zp = S.Z + (size_t)(ROW_SAMP + b0) * DIN + c;
        float* ohp = S.out + O_SRH + (size_t)b0 * DRNN + c; float* ocp = S.out + O_SRC + (size_t)b0 * 3 * DRNN + c;
#pragma unroll
        for (int tt = 0; tt < 32; ++tt) {
            const int g = tt >> 3, hh = (tt >> 2) & 1, j = tt & 3;
            const float pa = hh ? pa1[4 * g + j] : pa0[4 * g + j], px = hh ? px1[4 * g + j] : px0[4 * g + j];
            const float s0 = stp[0], s1 = stp[DRNN], s2 = stp[2 * DRNN];
            const float xn = bf2f(zp[ZC_XR]), gr = bf2f(zp[ZC_GR]);
            const float xc = kc.cb + kc.cw0 * s0 + kc.cw1 * s1 + kc.cw2 * s2 + kc.cw3 * xn;
            float oma, bb; lru_ab(kc, pa, px, xc, oma, bb);
            const float h0v = hp[0]; const float h = h0v - oma * h0v + bb;
            *(LAS float*)(lds + (size_t)tt * 4096 + c * 4) = h * gelu_tanh(gr);
            ohp[0] = h;
            ocp[0] = s1; ocp[DRNN] = s2; ocp[2 * DRNN] = xn;
            stp += 3 * DRNN; hp += DRNN; zp += DIN; ohp += DRNN; ocp += 3 * DRNN;
            asm volatile("" : "+v"(stp), "+v"(hp), "+v"(zp), "+v"(ohp), "+v"(ocp));
        }
    }
    __syncthreads();
    ytile_store(S.MIX, lds, wave, lane, [&](int tt) { return ROW_SAMP + b0 + tt; });
    __syncthreads();
}

constexpr int AT_K_OFF = 0, AT_VT_OFF = 49152, AT_VT_STRIDE = 392, AT_BIAS_OFF = AT_VT_OFF + 128 * AT_VT_STRIDE  , AT_LDS = AT_BIAS_OFF + 2048;
constexpr int N_QB = 129;
constexpr float ATT_SCALE = 0.08838834764831845f;
struct AttnIn { const bf16_t* Z; bf16_t* MIX; float* ssa; const float *cache_k, *cache_v, *sinks, *table; float* out; };

__device__ __forceinline__ void attn_prompt_unit(const AttnIn& A, LAS unsigned char* lds, int kvh, int qb, int tid) {
    const int wave = __builtin_amdgcn_readfirstlane(tid >> 6), lane = tid & 63, g = wave >> 1, qh = wave & 1, h = 4 * kvh + g;
    const int ql = lane & 31, hh = lane >> 5;
    const int tk0 = 64 * qb - 128;
#pragma unroll
    for (int i = 0; i < 6; ++i) {
        const int id = tid + 512 * i, key = id >> 4, c = id & 15, tk = tk0 + key;
        u32x4 kq = (u32x4){0u, 0u, 0u, 0u}, vq = (u32x4){0u, 0u, 0u, 0u};
        if (tk >= 0 && tk < TP) {
            const bf16_t* zr = A.Z + (size_t)tok2row(tk) * DIN + kvh * HD + 8 * c;
            kq = *(const u32x4*)(zr + ZC_K); vq = *(const u32x4*)(zr + ZC_V);
        }
        *(LAS u32x4*)(lds + AT_K_OFF + key * 256 + ((c ^ (key & 15)) << 4)) = kq;
        LAS unsigned short* vt = (LAS unsigned short*)(lds + AT_VT_OFF + (8 * c) * AT_VT_STRIDE + 2 * key);
        vt[0 * (AT_VT_STRIDE / 2)] = (unsigned short)(vq.x & 0xffffu); vt[1 * (AT_VT_STRIDE / 2)] = (unsigned short)(vq.x >> 16);
        vt[2 * (AT_VT_STRIDE / 2)] = (unsigned short)(vq.y & 0xffffu); vt[3 * (AT_VT_STRIDE / 2)] = (unsigned short)(vq.y >> 16);
        vt[4 * (AT_VT_STRIDE / 2)] = (unsigned short)(vq.z & 0xffffu); vt[5 * (AT_VT_STRIDE / 2)] = (unsigned short)(vq.z >> 16);
        vt[6 * (AT_VT_STRIDE / 2)] = (unsigned short)(vq.w & 0xffffu); vt[7 * (AT_VT_STRIDE / 2)] = (unsigned short)(vq.w >> 16);
    }
    { const int gg = tid >> 7, dist = tid & 127; ((LAS float*)(lds + AT_BIAS_OFF))[tid] = A.table[rel_bucket(dist) * NH + 4 * kvh + gg]; }
    const int tq = 64 * qb + 32 * qh + ql;
    bf16x8 bq[8];
    { const bf16_t* qp = A.Z + (size_t)tok2row(tq < TP ? tq : TP - 1) * DIN + ZC_Q + h * HD + 8 * hh;
#pragma unroll
      for (int s = 0; s < 8; ++s) bq[s] = __builtin_bit_cast(bf16x8, *(const u32x4*)(qp + 16 * s)); }
    __syncthreads();
    f32x16 st[5];
#pragma unroll
    for (int kb = 0; kb < 5; ++kb) {
        const int kk = 32 * (qh + kb) + ql;
        f32x16 acc = {};
#pragma unroll
        for (int s = 0; s < 8; ++s) {
            const bf16x8 ka = __builtin_bit_cast(bf16x8, *(const LAS u32x4*)(lds + AT_K_OFF + kk * 256 + (((2 * s + hh) ^ (kk & 15)) << 4)));
            acc = __builtin_amdgcn_mfma_f32_32x32x16_bf16(ka, bq[s], acc, 0, 0, 0);
        }
        st[kb] = acc;
    }
    const LAS float* sb = (const LAS float*)(lds + AT_BIAS_OFF) + g * 128;
    const float sink = A.sinks[h];
    float mx = -1e30f;
#pragma unroll
    for (int kb = 0; kb < 5; ++kb)
#pragma unroll
        for (int i = 0; i < 16; ++i) {
            const int r = (i & 3) + 8 * (i >> 2) + 4 * hh;
            const int dist = 128 + ql - 32 * kb - r, tk = tk0 + 32 * (qh + kb) + r;
            const bool ok = dist >= 0 && dist < 128 && tk >= 0;
            const float l = ok ? st[kb][i] * ATT_SCALE + sb[dist & 127] : -1e30f;
            st[kb][i] = l; mx = fmaxf(mx, l);
        }
    mx = fmaxf(max_x32(mx), sink);
    float sum = 0.f;
#pragma unroll
    for (int kb = 0; kb < 5; ++kb)
#pragma unroll
        for (int i = 0; i < 16; ++i) { const float p = st[kb][i] > -1e29f ? __expf(st[kb][i] - mx) : 0.f; st[kb][i] = p; sum += p; }
    sum = sum_x32(sum);
    sum += __expf(sink - mx);
    const float inv = 1.0f / sum;
    const int orow = tok2row(tq < TP ? tq : TP - 1);
    float ssq = 0.f;
#pragma unroll
    for (int dh = 0; dh < 2; ++dh) {
        f32x16 ot[2] = {};
#pragma unroll
        for (int kb = 0; kb < 5; ++kb)
#pragma unroll
            for (int s2 = 0; s2 < 2; ++s2) {
                u32x4 pp; pp.x = pk2(st[kb][8 * s2 + 0], st[kb][8 * s2 + 1]); pp.y = pk2(st[kb][8 * s2 + 2], st[kb][8 * s2 + 3]);
                pp.z = pk2(st[kb][8 * s2 + 4], st[kb][8 * s2 + 5]); pp.w = pk2(st[kb][8 * s2 + 6], st[kb][8 * s2 + 7]);
                const bf16x8 pf = __builtin_bit_cast(bf16x8, pp);
                const int kk0 = 32 * (qh + kb) + 16 * s2 + 4 * hh;
#pragma unroll
                for (int d2 = 0; d2 < 2; ++d2) {
                    const LAS unsigned char* vp = lds + AT_VT_OFF + (32 * (2 * dh + d2) + ql) * AT_VT_STRIDE + 2 * kk0;
                    const u32x2 lo = *(const LAS u32x2*)vp, hi = *(const LAS u32x2*)(vp + 16);
                    const bf16x8 va = __builtin_bit_cast(bf16x8, (u32x4){lo.x, lo.y, hi.x, hi.y});
                    ot[d2] = __builtin_amdgcn_mfma_f32_32x32x16_bf16(va, pf, ot[d2], 0, 0, 0);
                }
            }
        bf16_t* y = A.MIX + (size_t)orow * D + h * HD + 4 * hh + 64 * dh;
#pragma unroll
        for (int d2 = 0; d2 < 2; ++d2)
#pragma unroll
            for (int g4 = 0; g4 < 4; ++g4) {
                const float v0 = ot[d2][4 * g4] * inv, v1 = ot[d2][4 * g4 + 1] * inv, v2 = ot[d2][4 * g4 + 2] * inv, v3 = ot[d2][4 * g4 + 3] * inv;
                ssq += (v0 * v0 + v1 * v1) + (v2 * v2 + v3 * v3);
                if (tq < TP) *(u32x2*)(y + 32 * d2 + 8 * g4) = (u32x2){pk2(v0, v1), pk2(v2, v3)};
            }
    }
    ssq = sum_x32(ssq);
    if (tq < TP && hh == 0) atomicAdd(A.ssa + orow, ssq);
    __syncthreads();
}

__device__ __forceinline__ void attn_sample_item(const AttnIn& A, LAS unsigned char* lds, int b, int kvh, int tid) {
    LAS float* sq = (LAS float*)lds;
    LAS float* sl = sq + 512;
    LAS float* so = sl + 512;
    const int row = ROW_SAMP + b, lane = tid & 63, wave = tid >> 6;
    { const int gg = tid >> 7, d = tid & 127; sq[tid] = bf2f(A.Z[(size_t)row * DIN + ZC_Q + (4 * kvh + gg) * HD + d]) * ATT_SCALE; }
    __syncthreads();
    {
        const int w = tid >> 2, part = tid & 3, d0 = 32 * part;
        float kv[32];
        if (w < 127) {
            const f32x4* kp = (const f32x4*)(A.cache_k + (((size_t)b * WIN + w + 1) * NKV + kvh) * HD + d0);
#pragma unroll
            for (int e = 0; e < 8; ++e) { const f32x4 v = kp[e]; kv[4 * e] = v.x; kv[4 * e + 1] = v.y; kv[4 * e + 2] = v.z; kv[4 * e + 3] = v.w; }
        } else {
            const u32x4* kp = (const u32x4*)(A.Z + (size_t)row * DIN + ZC_K + kvh * HD + d0);
#pragma unroll
            for (int e = 0; e < 4; ++e) { const u32x4 q = kp[e]; kv[8 * e] = bflo(q.x); kv[8 * e + 1] = bfhi(q.x); kv[8 * e + 2] = bflo(q.y); kv[8 * e + 3] = bfhi(q.y);
                kv[8 * e + 4] = bflo(q.z); kv[8 * e + 5] = bfhi(q.z); kv[8 * e + 6] = bflo(q.w); kv[8 * e + 7] = bfhi(q.w); }
        }
        f32x4* ko = (f32x4*)(A.out + O_SK + (((size_t)b * WIN + w) * NKV + kvh) * HD + d0);
#pragma unroll
        for (int e = 0; e < 8; ++e) ko[e] = (f32x4){kv[4 * e], kv[4 * e + 1], kv[4 * e + 2], kv[4 * e + 3]};
        float dt[4] = {0.f, 0.f, 0.f, 0.f};
#pragma unroll
        for (int e = 0; e < 32; ++e) {
#pragma unroll
            for (int gg = 0; gg < 4; ++gg) dt[gg] += sq[gg * 128 + d0 + e] * kv[e];
        }
#pragma unroll
        for (int gg = 0; gg < 4; ++gg) { dt[gg] += swz_xor<1>(dt[gg]); dt[gg] += swz_xor<2>(dt[gg]); }
        const float mine = part == 0 ? dt[0] : part == 1 ? dt[1] : part == 2 ? dt[2] : dt[3];
        sl[part * 128 + w] = mine + A.table[rel_bucket(127 - w) * NH + 4 * kvh + part];
    }
    __syncthreads();
    if (wave < 4) {
        const float sink = A.sinks[4 * kvh + wave];
        const float l0 = sl[wave * 128 + lane], l1 = sl[wave * 128 + 64 + lane];
        const float mx = fmaxf(wave_max(fmaxf(l0, l1)), sink);
        const float e0 = __expf(l0 - mx), e1 = __expf(l1 - mx);
        const float inv = 1.0f / (wave_sum(e0 + e1) + __expf(sink - mx));
        sl[wave * 128 + lane] = e0 * inv; sl[wave * 128 + 64 + lane] = e1 * inv;
    }
    __syncthreads();
    {
        const int d = tid & 127, qt = tid >> 7;
        float acc[4] = {0.f, 0.f, 0.f, 0.f};
#pragma unroll 8
        for (int i = 0; i < 32; ++i) {
            const int w = 32 * qt + i;
            const float v = w < 127 ? A.cache_v[(((size_t)b * WIN + w + 1) * NKV + kvh) * HD + d] : bf2f(A.Z[(size_t)row * DIN + ZC_V + kvh * HD + d]);
            A.out[O_SV + (((size_t)b * WIN + w) * NKV + kvh) * HD + d] = v;
#pragma unroll
            for (int gg = 0; gg < 4; ++gg) acc[gg] += sl[gg * 128 + w] * v;
        }
#pragma unroll
        for (int gg = 0; gg < 4; ++gg) so[(qt * 4 + gg) * 128 + d] = acc[gg];
    }
    __syncthreads();
    { const int gg = tid >> 7, d = tid & 127;
      const float v = so[(0 * 4 + gg) * 128 + d] + so[(1 * 4 + gg) * 128 + d] + so[(2 * 4 + gg) * 128 + d] + so[(3 * 4 + gg) * 128 + d];
      A.MIX[(size_t)row * D + (4 * kvh + gg) * HD + d] = (bf16_t)f2bf(v);
      const float ss = wave_sum(v * v);
      if (lane == 0) atomicAdd(A.ssa + row, ss); }
    __syncthreads();
}

__device__ __forceinline__ void prompt_states(const bf16_t* Z, float* out, int tid) {
    for (int e = tid; e < 32768; e += 512) {
        const int d = e & 127, kvh = (e >> 7) & 1, wi = e >> 8;
        const bf16_t* z = Z + (size_t)tok2row(TP - WIN + wi) * DIN + kvh * HD + d;
        out[O_PK + e] = bf2f(z[ZC_K]); out[O_PV + e] = bf2f(z[ZC_V]);
    }
    for (int e = tid; e < 3072; e += 512) { const int c = e & 1023, j = e >> 10; out[O_PRC + e] = bf2f(Z[(size_t)tok2row(TP - 3 + j) * DIN + ZC_XR + c]); }
}
__device__ __forceinline__ void fixup_elem(bf16_t* ACT, const float* halo, const float* first, const float* cw, const float* cb, float* out, int i) {
    if (i < 128 * 2 * DFF) {
        const int ch = i % DFF, rr = (i / DFF) & 1, q = i / (2 * DFF);
        const int qp = q == 0 ? 128 : q - 1;
        const float h0 = halo[((size_t)qp * 2 + 0) * DFF + ch], h1 = halo[((size_t)qp * 2 + 1) * DFF + ch];
        const float u0 = first[((size_t)(q * 2 + 0) * 2 + 0) * DFF + ch], u1 = first[((size_t)(q * 2 + 1) * 2 + 0) * DFF + ch];
        const float g = first[((size_t)(q * 2 + rr) * 2 + 1) * DFF + ch];
        const float um2 = rr == 0 ? h0 : h1, um1 = rr == 0 ? h1 : u0, uc = rr == 0 ? u0 : u1;
        const float a = gelu_tanh(cb[ch] + cw[ch] * um2 + cw[DFF + ch] * um1 + cw[2 * DFF + ch] * uc) * g;
        ACT[(size_t)(q * 64 + rr) * DFF + ch] = (bf16_t)f2bf(a);
    } else if (i < 128 * 2 * DFF + 2 * DFF) {
        const int e = i - 128 * 2 * DFF;
        out[O_PFC + e] = halo[(size_t)127 * 2 * DFF + e];
    }
}

typedef __attribute__((address_space(1))) unsigned gu32;
#define XB_TMO      128
#define XB_XCNT(j)  (256  + 64 * (j))
#define XB_XSUB(j)  (1280 + 64 * (j))
#define XB_XGEN(j)  (2304 + 64 * (j))
#define XB_TOP      3328
#define XB_TOPGEN   3392
#define XCD_BAR_WORDS 3456
#define XB_SPIN_CAP (1u << 18)

__device__ __forceinline__ unsigned xb_ld(unsigned* p)              { return __hip_atomic_load(p, __ATOMIC_RELAXED, __HIP_MEMORY_SCOPE_AGENT); }
__device__ __forceinline__ unsigned xb_add(unsigned* p, unsigned v) { return __hip_atomic_fetch_add(p, v, __ATOMIC_RELAXED, __HIP_MEMORY_SCOPE_AGENT); }
__device__ __forceinline__ unsigned xb_xcc_id() { return (unsigned)__builtin_amdgcn_s_getreg((3 << 11) | 20) & 0xFu; }
#define XB_SPIN(cond, bar) do { unsigned _sp = 0; while (cond) { __builtin_amdgcn_s_sleep(1); \
    if ((++_sp & 255u) == 0u) { if (xb_ld(&(bar)[XB_TMO])) break; if (_sp > XB_SPIN_CAP) { atomicAdd(&(bar)[XB_TMO], 1u); break; } } } } while (0)

struct XcdBarrier {
    unsigned* bar; unsigned x;
    volatile LAS unsigned* st;
};

__device__ __forceinline__ XcdBarrier xcd_barrier_post(unsigned* bar, volatile LAS unsigned* st) {
    XcdBarrier b; b.bar = bar; b.x = xb_xcc_id(); b.st = st;
    if (threadIdx.x == 0) (void)xb_add(&bar[XB_XCNT(b.x)], 1u);
    return b;
}
__device__ __forceinline__ void xcd_barrier_complete(unsigned* bar, unsigned x, unsigned& nloc, unsigned& nx) {
    const unsigned G = gridDim.x * gridDim.y * gridDim.z;
    unsigned sum, cnt, mine, sp = 0u;
    for (;;) {
        sum = 0u; cnt = 0u; mine = 0u;
#pragma unroll
        for (unsigned j = 0; j < 16; ++j) { const unsigned c = xb_ld(&bar[XB_XCNT(j)]); sum += c; cnt += (c > 0u) ? 1u : 0u; mine = (j == x) ? c : mine; }
        if (sum == G) break;
        __builtin_amdgcn_s_sleep(1);
        if ((++sp & 255u) == 0u) { if (xb_ld(&bar[XB_TMO])) break; if (sp > XB_SPIN_CAP) { atomicAdd(&bar[XB_TMO], 1u); break; } }
    }
    nloc = mine > 0u ? mine : 1u; nx = cnt > 0u ? cnt : 1u;
}

__device__ __forceinline__ void xcd_barrier(const XcdBarrier& b, bool leader) {
    asm volatile("s_waitcnt vmcnt(0)" ::: "memory");
    __syncthreads();
    if (leader) {
        unsigned* bar = b.bar;
        __builtin_amdgcn_s_waitcnt(0);
        unsigned nloc = b.st[0], nx = b.st[1];
        if (nloc == 0u) { xcd_barrier_complete(bar, b.x, nloc, nx); b.st[0] = nloc; b.st[1] = nx; }
        const unsigned old = xb_add(&bar[XB_XSUB(b.x)], 1u);
        const unsigned gen = old / nloc;
        if (old + 1u == (gen + 1u) * nloc) {
            __builtin_amdgcn_fence(__ATOMIC_RELEASE, "agent");
            asm volatile("s_waitcnt vmcnt(0)" ::: "memory");
            const unsigned og = xb_add(&bar[XB_TOP], 1u);
            const unsigned tg = og / nx;
            if (og + 1u == (tg + 1u) * nx) xb_add(&bar[XB_TOPGEN], 1u);
            else XB_SPIN(xb_ld(&bar[XB_TOPGEN]) == tg, bar);
            __builtin_amdgcn_fence(__ATOMIC_ACQUIRE, "agent");
            xb_add(&bar[XB_XGEN(b.x)], 1u);
            asm volatile("s_waitcnt vmcnt(0)" ::: "memory");
        } else {
            XB_SPIN(xb_ld(&bar[XB_XGEN(b.x)]) == gen, bar);
            __builtin_amdgcn_fence(__ATOMIC_ACQUIRE, "agent");
            asm volatile("s_waitcnt vmcnt(0)" ::: "memory");
        }
    }
    __syncthreads();
}

constexpr int LDS_BYTES = 147456;
constexpr int MISC_OFF = LDS_BYTES - 256;
static_assert(pg8::STAGE_BYTES <= LDS_BYTES && AT_LDS <= LDS_BYTES, "LDS map");
typedef const __attribute__((address_space(4))) Params* KParams;
__device__ __forceinline__ KParams kparams() { KParams q = (KParams)__builtin_amdgcn_kernarg_segment_ptr(); asm volatile("" : "+s"(q)); return q; }
#define PHASE_BEGIN() \
    KParams p = kparams(); \
    int wave = wave_s; asm volatile("" : "+s"(wave)); const int lane = fresh_lane(); const int tid = wave * 64 + lane; (void)tid; \
    unsigned char* ws = p->ws; float* out = p->out; (void)out; \
    bf16_t *Wt_in = (bf16_t*)(ws + WS_WIN), *Wt_out = (bf16_t*)(ws + WS_WOUT), *Wt_ug = (bf16_t*)(ws + WS_WUG), *Wt_dn = (bf16_t*)(ws + WS_WDN); (void)Wt_in; (void)Wt_out; (void)Wt_ug; (void)Wt_dn; \
    bf16_t *H0 = (bf16_t*)(ws + WS_H0), *Z = (bf16_t*)(ws + WS_Z), *MIX = (bf16_t*)(ws + WS_MIX), *ACT = (bf16_t*)(ws + WS_ACT), *X1b = (bf16_t*)(ws + WS_X1B); (void)H0; (void)Z; (void)MIX; (void)ACT; (void)X1b; \
    float *XS = (float*)(ws + WS_XS), *ssa = (float*)(ws + WS_SSA), *ss1 = (float*)(ws + WS_RS1), *halo = (float*)(ws + WS_HALO), *first = (float*)(ws + WS_FIRST); (void)ssa; (void)ss1; (void)halo; (void)first; \
    XIn X; X.xp = p->x_prompt; X.meta = p->meta; X.xsamp = p->x_sample; (void)X; \
    RowMap R; R.out = out; R.xs = XS; (void)R
#define SCAN_IN() ScanIn SI; SI.Z = Z; SI.R = R; SI.MIX = MIX; SI.st_conv = p->st_conv; SI.st_h = p->st_h; SI.conv_w = p->conv_w; SI.conv_b = p->conv_b; SI.ga_b = p->ga_b; SI.gx_b = p->gx_b; SI.lam = p->lam; \
    SI.gwf = (const u32x4*)(ws + WS_GWF); SI.sumA = (float*)(ws + WS_SUMA); SI.sumB = (float*)(ws + WS_SUMB); SI.sumHA = (float*)(ws + WS_SUMHA); SI.sumHB = (float*)(ws + WS_SUMHB); \
    SI.oma = (bf16_t*)(out + O_Y); SI.bb = SI.oma + (size_t)MP * DRNN; SI.out = out

__global__ void __launch_bounds__(512, 2) mega(Params p_unused) {
    extern __shared__ __attribute__((aligned(16))) unsigned char lds_raw[];
    LAS unsigned char* lds = (LAS unsigned char*)lds_raw;
    cg::grid_group grid = cg::this_grid();
    const int bid = blockIdx.x, G = gridDim.x;
    const int wave_s = __builtin_amdgcn_readfirstlane(threadIdx.x >> 6);
    volatile LAS unsigned* MISC = (volatile LAS unsigned*)(lds + MISC_OFF);
    if (threadIdx.x < 64) MISC[threadIdx.x] = 0u;
    __syncthreads();
    XcdBarrier bar;
    { KParams p = kparams(); bar = xcd_barrier_post((unsigned*)(p->ws + WS_CTL), MISC + 8); }

    {
        PHASE_BEGIN();
        WPrep W; W.w_in = p->w_in; W.w_out = p->w_out; W.w_up = p->w_up; W.w_gate = p->w_gate; W.w_down = p->w_down; W.g_mix = p->norm_mix; W.g_rnn = p->norm_rnn; W.g_attn = p->norm_attn; W.g_ffn = p->norm_ffn;
        W.t_in = Wt_in; W.t_out = Wt_out; W.t_ug = Wt_ug; W.t_dn = Wt_dn;
        const int half = tid >> 8;
        LAS float* s = (LAS float*)(lds + half * 16896);
        {
            const int t256 = tid & 255;
            int it = 2 * bid + half;
            f32x4 cur[4];
            WTile tc = wprep_decode(W, it < WT_TOTAL ? it : 0);
            if (it < WT_TOTAL) wprep_load(tc, t256, cur);
            while (it < WT_TOTAL) {
                const int nx = it + 2 * G;
                f32x4 nxt[4];
                const WTile tn = wprep_decode(W, nx < WT_TOTAL ? nx : it);
                wprep_load(tn, t256, nxt);
                wprep_store(W, tc, t256, cur, s);
#pragma unroll
                for (int i = 0; i < 4; ++i) cur[i] = nxt[i];
                tc = tn; it = nx;
            }
        }
        for (int i = bid * 512 + tid; i < 16384; i += G * 512) prep_gwf_frag(p->ga_w, p->gx_w, (u32x4*)(ws + WS_GWF), i);
        for (int row = bid * 8 + wave; row < MP; row += G * 8) prep_row(X, H0, row, lane);
        for (int i = bid * 512 + tid; i < 2 * MP; i += G * 512) ssa[i] = 0.f;
    }
    grid.sync();
    {
        PHASE_BEGIN();
        Gemm g; g.A = H0; g.Bt = Wt_in; g.M = MP; g.N = DIN; g.K = D;
        pg8::StaticOrder S; S.init(MP, DIN, G, bid);
        pg8::EpiZ E; E.O = Z; E.ldc = DIN;
        pg8::gemm_phase<pg8::EpiZ, pg8::StaticOrder, true, true>(lds, g, S, E, tid);
    }
    xcd_barrier(bar, wave_s == 0 && fresh_lane() == 0);
    {
        PHASE_BEGIN();
        SCAN_IN();
        AttnIn A; A.Z = Z; A.MIX = MIX; A.ssa = ssa; A.cache_k = p->cache_k; A.cache_v = p->cache_v; A.sinks = p->sinks; A.table = p->table; A.out = out;
        for (int it = bid; it < 2 * N_QB; it += G) attn_prompt_unit(A, lds, it & 1, it >> 1, tid);
        for (int it = bid; it < 2 * NSAMP; it += G) attn_sample_item(A, lds, it >> 1, it & 1, tid);
        for (int it = (bid + G - (120 % G)) % G; it < 4; it += G) rglru_sample_out(SI, lds, it, wave, lane);
        for (int it = G - 1 - bid; it < 2 * NCHUNK; it += G) rglru_passA(SI, (2 * NCHUNK - 1 - it) >> 1, (2 * NCHUNK - 1 - it) & 1, wave, lane);
        if (bid == (G > 2 ? 2 : 0)) prompt_states(Z, out, tid);
    }
    xcd_barrier(bar, wave_s == 0 && fresh_lane() == 0);
    {
        PHASE_BEGIN();
        SCAN_IN();
        for (int it = bid; it < 129; it += G) rglru_passB(SI, lds, 128 - it, wave, lane);
    }
    xcd_barrier(bar, wave_s == 0 && fresh_lane() == 0);
    {
        PHASE_BEGIN();
        Gemm g; g.A = MIX; g.Bt = Wt_out; g.M = MP; g.N = D; g.K = D;
        pg8::StaticOrder S; S.init(MP, D, G, bid);
        pg8::EpiOut E; E.R = R; E.X = X; E.X1b = X1b; E.ssa = ssa; E.ss1 = ss1;
        pg8::gemm_phase<pg8::EpiOut, pg8::StaticOrder, true, true>(lds, g, S, E, tid);
    }
    xcd_barrier(bar, wave_s == 0 && fresh_lane() == 0);
    {
        PHASE_BEGIN();
        Gemm g; g.A = X1b; g.Bt = Wt_ug; g.M = MP; g.N = 2 * DFF; g.K = D;
        pg8::StaticOrder S; S.init(MP, 2 * DFF, G, bid);
        pg8::EpiUG E; E.ws = ws; E.o_act = WS_ACT; E.o_ss1 = WS_RS1; E.o_halo = WS_HALO; E.o_first = WS_FIRST; E.cw = p->fconv_w; E.cb = p->fconv_b; E.st = p->st_ffn; E.out_sfc = out + O_SFC;
        pg8::gemm_phase<pg8::EpiUG, pg8::StaticOrder, true, true>(lds, g, S, E, tid);
    }
    xcd_barrier(bar, wave_s == 0 && fresh_lane() == 0);
    {
        PHASE_BEGIN();
        Gemm g; g.A = ACT; g.Bt = Wt_dn; g.M = MP; g.N = D; g.K = DFF;
        pg8::StaticOrder S; S.init(MP, D, G, bid);
        pg8::Unit u;
        for (int i = 0; S.next(i, u); ++i)
            if (u.pm < NBIG / 256)
                for (int e = tid; e < 8 * DFF; e += 512) fixup_elem(ACT, halo, first, p->fconv_w, p->fconv_b, out, (8 * u.pm) * DFF + e);
        if (bid == 0) for (int e = tid; e < 2 * DFF; e += 512) fixup_elem(ACT, halo, first, p->fconv_w, p->fconv_b, out, 128 * 2 * DFF + e);
        asm volatile("s_waitcnt vmcnt(0)" ::: "memory");
        __syncthreads();
        pg8::EpiRes E; E.R = R; E.X = X; E.mode = 1; E.pad_ = 0;
        pg8::gemm_phase<pg8::EpiRes, pg8::StaticOrder, true, true>(lds, g, S, E, tid);
    }
    xcd_barrier(bar, wave_s == 0 && fresh_lane() == 0);
    {
        PHASE_BEGIN();
        for (int r = bid * 8 + wave; r < NBIG + NSAMP; r += G * 8) final_row(out, p->norm_final, r, lane);
    }
}

extern "C" void kernel_launch(void* const* d_in, const int* in_sizes, int n_in, void* d_out, int out_size, void* d_ws, size_t ws_size, hipStream_t stream) {
    static int grid = 0;
    if (ws_size < WS_END) return;
    if (grid == 0) {
        if (n_in != 29 || out_size != (int)O_END || ws_size < WS_END) fprintf(stderr, "kernel_launch: unexpected shapes n_in %d out %d ws %zu (need %zu)\n", n_in, out_size, ws_size, (size_t)WS_END);
        int dev = 0, cus = 0, per_cu = 0;
        (void)hipGetDevice(&dev);
        (void)hipDeviceGetAttribute(&cus, hipDeviceAttributeMultiprocessorCount, dev);
        (void)hipFuncSetAttribute((const void*)mega, hipFuncAttributeMaxDynamicSharedMemorySize, LDS_BYTES);
        (void)hipOccupancyMaxActiveBlocksPerMultiprocessor(&per_cu, (const void*)mega, 512, LDS_BYTES);
        if (per_cu < 1) { fprintf(stderr, "kernel_launch: occupancy query says %d blocks per CU\n", per_cu); per_cu = 1; }
        grid = cus * per_cu;
        if (grid <= 0) grid = 256;
    }
    Params p; memset(&p, 0, sizeof p);
    const float* const* in = (const float* const*)d_in;
    p.x_prompt = in[0]; p.x_sample = in[1]; p.st_conv = in[2]; p.st_h = in[3]; p.cache_k = in[4]; p.cache_v = in[5]; p.st_ffn = in[6]; p.meta = in[7]; p.table = in[8];
    p.norm_mix = in[9]; p.w_in = in[10]; p.conv_w = in[11]; p.conv_b = in[12]; p.ga_w = in[13]; p.ga_b = in[14]; p.gx_w = in[15]; p.gx_b = in[16]; p.lam = in[17]; p.sinks = in[18];
    p.norm_rnn = in[19]; p.norm_attn = in[20]; p.w_out = in[21]; p.norm_ffn = in[22]; p.w_up = in[23]; p.w_gate = in[24]; p.fconv_w = in[25]; p.fconv_b = in[26]; p.w_down = in[27]; p.norm_final = in[28];
    p.out = (float*)d_out; p.ws = (unsigned char*)d_ws;
    (void)hipMemsetAsync((unsigned char*)d_ws + WS_CTL, 0, 16384, stream);
    void* args[] = {&p};
    hipError_t e = hipLaunchCooperativeKernel((const void*)mega, dim3(grid), dim3(512), args, LDS_BYTES, stream);
    if (e != hipSuccess) fprintf(stderr, "kernel_launch: cooperative launch failed: %s (grid %d)\n", hipGetErrorString(e), grid);
}
```

```cpp
#include <hip/hip_runtime.h>
#include <hip/hip_cooperative_groups.h>
#include <cstdio>
#include <cstdint>
#include <cstring>

constexpr int D = 2048, NBIG = 8192, NMETA = 16, NSAMP = 128, TP = NBIG + NMETA  ;
constexpr int MROWS = NBIG + NMETA + NSAMP  , MP = 8448  ;
constexpr int DRNN = 1024, DATT = 1024, DIN = 3584, DFF = 6144, HD = 128, NH = 8, NKV = 2, WIN = 128;
constexpr int ZC_XR = 0, ZC_GR = 1024, ZC_Q = 2048, ZC_K = 3072, ZC_V = 3328;
constexpr int ROW_META = NBIG, ROW_SAMP = NBIG + NMETA;
constexpr float EPS = 1e-6f;
__host__ __device__ __forceinline__ int tok2row(int t) { return t >= NMETA ? t - NMETA : ROW_META + t; }

constexpr size_t O_Y = 0, O_YS = 16777216, O_PRC = 17039360, O_PRH = 17042432, O_PK = 17043456, O_PV = 17076224, O_PFC = 17108992,
                 O_SRC = 17121280, O_SRH = 17514496, O_SK = 17645568, O_SV = 21839872, O_SFC = 26034176, O_END = 27607040;

typedef unsigned short bf16_t;
typedef float f32x4 __attribute__((ext_vector_type(4)));
typedef float f32x2 __attribute__((ext_vector_type(2)));
typedef unsigned u32x4 __attribute__((ext_vector_type(4)));
typedef unsigned u32x2 __attribute__((ext_vector_type(2)));

__device__ __forceinline__ float bf2f(bf16_t b) { return __uint_as_float(((unsigned)b) << 16); }
__device__ __forceinline__ unsigned f2bf(float f) { unsigned u = __float_as_uint(f); return (u + 0x7fffu + ((u >> 16) & 1u)) >> 16; }
__device__ __forceinline__ unsigned pk2(float lo, float hi) { return f2bf(lo) | (f2bf(hi) << 16); }
template <int XM> __device__ __forceinline__ float swz_xor(float v) {
    return __int_as_float(__builtin_amdgcn_ds_swizzle(__float_as_int(v), (XM << 10) | 0x1f)); }
__device__ __forceinline__ float sum_x32(float v) { auto r = __builtin_amdgcn_permlane32_swap(__float_as_uint(v), __float_as_uint(v), false, false); return __uint_as_float(r[0]) + __uint_as_float(r[1]); }
__device__ __forceinline__ float max_x32(float v) { auto r = __builtin_amdgcn_permlane32_swap(__float_as_uint(v), __float_as_uint(v), false, false); return fmaxf(__uint_as_float(r[0]), __uint_as_float(r[1])); }
__device__ __forceinline__ float wave_sum(float v) {
    v += swz_xor<1>(v); v += swz_xor<2>(v); v += swz_xor<4>(v); v += swz_xor<8>(v); v += swz_xor<16>(v);
    return sum_x32(v);
}
__device__ __forceinline__ float wave_max(float v) {
    v = fmaxf(v, swz_xor<1>(v)); v = fmaxf(v, swz_xor<2>(v)); v = fmaxf(v, swz_xor<4>(v)); v = fmaxf(v, swz_xor<8>(v)); v = fmaxf(v, swz_xor<16>(v));
    return max_x32(v);
}
__device__ __forceinline__ float gelu_tanh(float x) {
    const float e = __builtin_amdgcn_exp2f(x * (1.0f + 0.044715f * x * x) * (-2.3022081985f));
    return x * __builtin_amdgcn_rcpf(1.0f + e);
}
__device__ __forceinline__ float sigmoid_f(float x) { return __builtin_amdgcn_rcpf(1.0f + __builtin_amdgcn_exp2f(x * (-1.4426950409f))); }

struct RowMap { float* out; float* xs; };
__device__ __forceinline__ float* xrow_ptr(const RowMap& R, int row) {
    if (row < NBIG) return R.out + O_Y + (size_t)row * D;
    if (row < ROW_SAMP) return R.xs + (size_t)(row - ROW_META) * D;
    if (row < MROWS) return R.out + O_YS + (size_t)(row - ROW_SAMP) * D;
    return nullptr;
}
struct XIn { const float* xp; const float* meta; const float* xsamp; };
__device__ __forceinline__ const float* xin_ptr(const XIn& X, int row) {
    if (row < NBIG) return X.xp + (size_t)row * D;
    if (row < ROW_SAMP) return X.meta + (size_t)(row - ROW_META) * D;
    if (row < MROWS) return X.xsamp + (size_t)(row - ROW_SAMP) * D;
    return nullptr;
}
namespace pg8 {
#define PG8_LAS __attribute__((address_space(3)))
typedef unsigned short bf16_t;
typedef short bf16x8 __attribute__((ext_vector_type(8)));
typedef float f32x4 __attribute__((ext_vector_type(4)));
typedef unsigned u32x4 __attribute__((ext_vector_type(4)));
constexpr int BM = 256, BK = 64, HALF = 128, HTB = HALF * BK * 2  , STAGE_BYTES = 8 * HTB, NXCD = 8, WGM = 8;

__host__ __device__ __forceinline__ int lds_byte(int r, int c) { const int st = (r >> 4) * 2 + (c >> 5), rr = r & 15, cc = c & 31, ob = rr * 64 + cc * 2; return st * 1024 + (ob ^ (((ob >> 9) & 1) << 5)); }
__host__ __device__ __forceinline__ void stage_rc(int b, int& R, int& C) { const int st = b / 1024, sb = b % 1024, swz = sb ^ (((sb >> 9) & 1) << 5); R = (st >> 1) * 16 + swz / 64; C = (st & 1) * 32 + (swz % 64) / 2; }
__host__ __device__ __forceinline__ int perm32(int rho) { const int n = rho >> 4, i = rho & 15; return 8 * (i >> 2) + 4 * n + (i & 3); }

struct Unit { int pm, pn; };
struct Gemm { const bf16_t* A; const bf16_t* Bt; int M, N, K; };

struct StaticOrder {
    int nM, nN, nwg, G, c;
    __host__ __device__ __forceinline__ void init(int M, int N, int G_, int c_) { nM = M / BM; nN = N / BM; nwg = nM * nN; G = G_; c = c_; }
    __host__ __device__ __forceinline__ bool next(int i, Unit& u) const {
        const long L = (long)i * G + c; if (L >= nwg) return false;
        int wgid = (int)L; { const int q = nwg / NXCD, r = nwg % NXCD, xcd = wgid % NXCD, off = wgid / NXCD; wgid = (xcd < r ? xcd * (q + 1) : r * (q + 1) + (xcd - r) * q) + off; }
        const int nig = WGM * nN, gid = wgid / nig, fm = gid * WGM, gsz = (nM - fm) < WGM ? (nM - fm) : WGM;
        u.pm = fm + ((wgid % nig) % gsz); u.pn = (wgid % nig) / gsz; return true;
    }
    __device__ __forceinline__ void a_ready(const Unit&) const {}
    __device__ __forceinline__ void done(const Unit&) const {}
};

__device__ __forceinline__ unsigned cvt_pk_bf16(float lo, float hi) { unsigned r; asm volatile("v_cvt_pk_bf16_f32 %0, %1, %2" : "=v"(r) : "v"(lo), "v"(hi)); return r; }

struct EpiZ {
    static constexpr bool PERM = true, AFTER_DRAIN = false, MIDK = false;
    bf16_t* O; int ldc;
    __device__ __forceinline__ void operator()(const f32x4 (&acc)[2][2][4][2], const Unit& u, int wr, int wc, int fr, int fq) const {
        const int row0 = u.pm * BM + wr * 64 + fr, col0 = u.pn * BM + wc * 32 + 8 * fq;
#pragma unroll
        for (int ai = 0; ai < 2; ++ai)
#pragma unroll
            for (int m = 0; m < 4; ++m) { bf16_t* rowp = O + (size_t)(row0 + ai * HALF + m * 16) * ldc + col0;
#pragma unroll
                for (int bj = 0; bj < 2; ++bj) { const f32x4 v0 = acc[ai][bj][m][0], v1 = acc[ai][bj][m][1];
                    u32x4 w; w.x = cvt_pk_bf16(v0[0], v0[1]); w.y = cvt_pk_bf16(v0[2], v0[3]); w.z = cvt_pk_bf16(v1[0], v1[1]); w.w = cvt_pk_bf16(v1[2], v1[3]);
                    *(u32x4*)(rowp + bj * HALF) = w; } }
    }
};

struct EpiRes {
    static constexpr bool PERM = false, AFTER_DRAIN = false, MIDK = false;
    RowMap R; XIn X; int mode; int pad_;
    __device__ __forceinline__ void operator()(const f32x4 (&acc)[2][2][4][2], const Unit& u, int wr, int wc, int fr, int fq) const {
        const int col0 = u.pn * BM + wc * 32 + 4 * fq;
#pragma unroll
        for (int ai = 0; ai < 2; ++ai)
#pragma unroll
            for (int m = 0; m < 4; ++m) {
                const int row = u.pm * BM + ai * HALF + wr * 64 + m * 16 + fr;
                float* d = xrow_ptr(R, row);
                if (d) {
                    const float* b = mode == 0 ? xin_ptr(X, row) : d;
#pragma unroll
                    for (int bj = 0; bj < 2; ++bj)
#pragma unroll
                        for (int n = 0; n < 2; ++n) { const int off = col0 + bj * HALF + n * 16; *(f32x4*)(d + off) = *(const f32x4*)(b + off) + acc[ai][bj][m][n]; }
                }
            }
    }
};


struct EpiOut {
    static constexpr bool PERM = false, AFTER_DRAIN = false, MIDK = true;
    RowMap R; XIn X; bf16_t* X1b; const float* ssa; float* ss1;
    __device__ __forceinline__ void mid(f32x4 (&acc)[2][2][4][2], const Unit& u, int wr, int wc, int fr, int fq) const {
#pragma unroll
        for (int ai = 0; ai < 2; ++ai)
#pragma unroll
            for (int m = 0; m < 4; ++m) {
                const int row = u.pm * BM + ai * HALF + wr * 64 + m * 16 + fr;
                const float f = row < MROWS ? 1.0f / sqrtf(ssa[row] * (1.0f / DATT) + EPS) : 0.f;
#pragma unroll
                for (int bj = 0; bj < 2; ++bj)
#pragma unroll
                    for (int n = 0; n < 2; ++n) acc[ai][bj][m][n] *= f;
            }
    }
    __device__ __forceinline__ void operator()(const f32x4 (&acc)[2][2][4][2], const Unit& u, int wr, int wc, int fr, int fq) const {
        const int col0 = u.pn * BM + wc * 32 + 4 * fq;
#pragma unroll
        for (int ai = 0; ai < 2; ++ai)
#pragma unroll
            for (int m = 0; m < 4; ++m) {
                const int row = u.pm * BM + ai * HALF + wr * 64 + m * 16 + fr;
                float* d = xrow_ptr(R, row);
                if (d) {
                    const float* b = xin_ptr(X, row);
                    bf16_t* xb = X1b + (size_t)row * D;
                    float ss = 0.f;
#pragma unroll
                    for (int bj = 0; bj < 2; ++bj)
#pragma unroll
                        for (int n = 0; n < 2; ++n) { const int off = col0 + bj * HALF + n * 16; const f32x4 v = *(const f32x4*)(b + off) + acc[ai][bj][m][n];
                            *(f32x4*)(d + off) = v; *(u32x2*)(xb + off) = (u32x2){cvt_pk_bf16(v[0], v[1]), cvt_pk_bf16(v[2], v[3])};
                            ss += (v[0] * v[0] + v[1] * v[1]) + (v[2] * v[2] + v[3] * v[3]); }
                    ss += swz_xor<16>(ss); ss = sum_x32(ss);
                    if (fq == 0) atomicAdd(ss1 + row, ss);
                }
            }
    }
};

struct EpiUG {
    static constexpr bool PERM = true, AFTER_DRAIN = false, MIDK = false;
    unsigned char* ws; size_t o_act, o_ss1, o_halo, o_first; const float* cw; const float* cb; const float* st; float* out_sfc;
    __device__ __forceinline__ void operator()(const f32x4 (&acc)[2][2][4][2], const Unit& u, int wr, int wc, int fr, int fq) const {
        bf16_t* ACT = (bf16_t*)(ws + o_act); const float* rs1 = (const float*)(ws + o_ss1); float* halo = (float*)(ws + o_halo); float* first = (float*)(ws + o_first);
        const int lane = (fq << 4) | fr;
        const int ch0 = u.pn * 128 + wc * 32 + 8 * fq;
        float w0[8], w1[8], w2[8], b0[8];
#pragma unroll
        for (int h = 0; h < 2; ++h) {
            const f32x4 a = *(const f32x4*)(cw + ch0 + 4 * h), b = *(const f32x4*)(cw + DFF + ch0 + 4 * h), c = *(const f32x4*)(cw + 2 * DFF + ch0 + 4 * h), d = *(const f32x4*)(cb + ch0 + 4 * h);
#pragma unroll
            for (int j = 0; j < 4; ++j) { w0[4 * h + j] = a[j]; w1[4 * h + j] = b[j]; w2[4 * h + j] = c[j]; b0[4 * h + j] = d[j]; }
        }
        const int src1 = (lane & 48) | ((fr + 15) & 15), src2 = (lane & 48) | ((fr + 14) & 15);
#pragma unroll
        for (int ai = 0; ai < 2; ++ai) {
            float pu[8];
#pragma unroll
            for (int e = 0; e < 8; ++e) pu[e] = 0.f;
#pragma unroll
            for (int m = 0; m < 4; ++m) {
                const int R0 = u.pm * BM + ai * HALF + wr * 64 + m * 16, row = R0 + fr;
                if (R0 >= MROWS) continue;
                const float rs = 1.0f / sqrtf(rs1[row] * (1.0f / D) + EPS);
                float uu[8], gg[8];
#pragma unroll
                for (int n = 0; n < 2; ++n)
#pragma unroll
                    for (int j = 0; j < 4; ++j) { uu[4 * n + j] = acc[ai][0][m][n][j] * rs; gg[4 * n + j] = acc[ai][1][m][n][j] * rs; }
                if (R0 < NBIG) {
                    float act[8];
#pragma unroll
                    for (int e = 0; e < 8; ++e) {
                        const float c1 = __shfl(uu[e], src1), c2 = __shfl(uu[e], src2), p1 = __shfl(pu[e], src1), p2 = __shfl(pu[e], src2);
                        const float um1 = fr >= 1 ? c1 : p1, um2 = fr >= 2 ? c2 : p2;
                        act[e] = gelu_tanh(b0[e] + w0[e] * um2 + w1[e] * um1 + w2[e] * uu[e]) * gg[e];
                    }
                    const int q = R0 >> 6;
                    if (m == 0 && fr < 2) {
                        float* f = first + ((size_t)(q * 2 + fr) * 2) * DFF + ch0;
                        *(f32x4*)(f) = (f32x4){uu[0], uu[1], uu[2], uu[3]}; *(f32x4*)(f + 4) = (f32x4){uu[4], uu[5], uu[6], uu[7]};
                        *(f32x4*)(f + DFF) = (f32x4){gg[0], gg[1], gg[2], gg[3]}; *(f32x4*)(f + DFF + 4) = (f32x4){gg[4], gg[5], gg[6], gg[7]};
                    } else {
                        u32x4 w; w.x = cvt_pk_bf16(act[0], act[1]); w.y = cvt_pk_bf16(act[2], act[3]); w.z = cvt_pk_bf16(act[4], act[5]); w.w = cvt_pk_bf16(act[6], act[7]);
                        *(u32x4*)(ACT + (size_t)row * DFF + ch0) = w;
                    }
                    if (m == 3 && fr >= 14) {
                        float* f = halo + ((size_t)q * 2 + (fr - 14)) * DFF + ch0;
                        *(f32x4*)(f) = (f32x4){uu[0], uu[1], uu[2], uu[3]}; *(f32x4*)(f + 4) = (f32x4){uu[4], uu[5], uu[6], uu[7]};
                    }
#pragma unroll
                    for (int e = 0; e < 8; ++e) pu[e] = uu[e];
                } else if (R0 == ROW_META) {
                    if (fr >= 14) {
                        float* f = halo + ((size_t)128 * 2 + (fr - 14)) * DFF + ch0;
                        *(f32x4*)(f) = (f32x4){uu[0], uu[1], uu[2], uu[3]}; *(f32x4*)(f + 4) = (f32x4){uu[4], uu[5], uu[6], uu[7]};
                    }
                } else {
                    const int b = row - ROW_SAMP;
                    const float* s0p = st + ((size_t)b * 2) * DFF + ch0; const float* s1p = s0p + DFF;
                    const f32x4 s0a = *(const f32x4*)s0p, s0b = *(const f32x4*)(s0p + 4), s1a = *(const f32x4*)s1p, s1b = *(const f32x4*)(s1p + 4);
                    float act[8];
#pragma unroll
                    for (int e = 0; e < 8; ++e) {
                        const float h0 = e < 4 ? s0a[e & 3] : s0b[e & 3], h1 = e < 4 ? s1a[e & 3] : s1b[e & 3];
                        act[e] = gelu_tanh(b0[e] + w0[e] * h0 + w1[e] * h1 + w2[e] * uu[e]) * gg[e];
                    }
                    u32x4 w; w.x = cvt_pk_bf16(act[0], act[1]); w.y = cvt_pk_bf16(act[2], act[3]); w.z = cvt_pk_bf16(act[4], act[5]); w.w = cvt_pk_bf16(act[6], act[7]);
                    *(u32x4*)(ACT + (size_t)row * DFF + ch0) = w;
                    float* o = out_sfc + ((size_t)b * 2) * DFF + ch0;
                    *(f32x4*)(o) = s1a; *(f32x4*)(o + 4) = s1b;
                    *(f32x4*)(o + DFF) = (f32x4){uu[0], uu[1], uu[2], uu[3]}; *(f32x4*)(o + DFF + 4) = (f32x4){uu[4], uu[5], uu[6], uu[7]};
                }
            }
        }
    }
};

template <class Epi, class Sched, bool ALIGN_EPI = false, bool SP2 = false>
__device__ __forceinline__ void gemm_phase(PG8_LAS unsigned char* lds, const Gemm g, const Sched& S, const Epi& E, int tid_in) {
    int tid_ = tid_in; asm volatile("" : "+v"(tid_));
    const int tid = tid_, wid = __builtin_amdgcn_readfirstlane(tid >> 6), lane = tid & 63, wr = wid >> 2, wc = wid & 3, fr = lane & 15, fq = lane >> 4;
    const int K = g.K, nt = K / BK;
    unsigned voffA[2], voffB[2];
#pragma unroll
    for (int i = 0; i < 2; ++i) { int R, C; stage_rc(tid * 16 + i * 8192, R, C); const int Rb = Epi::PERM ? ((R & ~31) + perm32(R & 31)) : R;
        voffA[i] = (unsigned)(R * K + C) * 2u; voffB[i] = (unsigned)(Rb * K + C) * 2u; }
    const size_t kstep = (size_t)(BK * 2);
    const size_t hstep = (size_t)HALF * K * 2;
    const size_t tstep = 2 * hstep;
    const unsigned ldsw = (unsigned)wid * 1024u;
    const int aoff = lds_byte(wr * 64 + fr, fq * 8), boff = lds_byte(wc * 32 + fr, fq * 8);
#define PG8_SA(b, h) (((b) * 2 + (h)) * HTB)
#define PG8_SB(b, h) ((4 + (b) * 2 + (h)) * HTB)
#define PG8_STAGE(bufoff, gbase, voff) do { _Pragma("unroll") for (int _i = 0; _i < 2; ++_i) \
        __builtin_amdgcn_global_load_lds((const unsigned*)((const char*)(gbase) + (voff)[_i]), (PG8_LAS unsigned*)(lds + (bufoff) + ldsw + _i * 8192), 16, 0, 0); } while (0)
#define PG8_LDA(dst, b, h) do { _Pragma("unroll") for (int m = 0; m < 4; ++m) _Pragma("unroll") for (int k = 0; k < 2; ++k) dst[m][k] = *(const PG8_LAS bf16x8*)(lds + PG8_SA(b, h) + aoff + m * 2048 + k * 1024); } while (0)
#define PG8_LDB(dst, b, h) do { _Pragma("unroll") for (int n = 0; n < 2; ++n) _Pragma("unroll") for (int k = 0; k < 2; ++k) dst[n][k] = *(const PG8_LAS bf16x8*)(lds + PG8_SB(b, h) + boff + n * 2048 + k * 1024); } while (0)
#define PG8_MMA(ai, bj, At, Bt) do { __builtin_amdgcn_s_setprio(1); _Pragma("unroll") for (int m = 0; m < 4; ++m) _Pragma("unroll") for (int n = 0; n < 2; ++n) _Pragma("unroll") for (int k = 0; k < 2; ++k) \
        acc[ai][bj][m][n] = __builtin_amdgcn_mfma_f32_16x16x32_bf16(Bt[n][k], At[m][k], acc[ai][bj][m][n], 0, 0, 0); __builtin_amdgcn_s_setprio(0); } while (0)
#define PG8_WAIT_V(n) asm volatile("s_waitcnt vmcnt(" #n ")" ::: "memory")
#define PG8_WAIT_L(n) asm volatile("s_waitcnt lgkmcnt(" #n ")" ::: "memory")
#define PG8_BAR __builtin_amdgcn_s_barrier()
#define PG8_SCHED __builtin_amdgcn_sched_barrier(0)
    Unit cur, nxt; int ui = 0;
    if (!S.next(0, cur)) return;
    f32x4 acc[2][2][4][2];
#pragma unroll
    for (int a = 0; a < 2; ++a)
#pragma unroll
        for (int b = 0; b < 2; ++b)
#pragma unroll
            for (int m = 0; m < 4; ++m)
#pragma unroll
                for (int n = 0; n < 2; ++n) acc[a][b][m][n] = (f32x4){0.f, 0.f, 0.f, 0.f};
    bf16x8 At[4][2], B0[2][2], B1[2][2];
    const char* cA = (const char*)g.A + (size_t)cur.pm * tstep; const char* cB = (const char*)g.Bt + (size_t)cur.pn * tstep;
    S.a_ready(cur);
    if constexpr (SP2) {
        PG8_STAGE(PG8_SB(0, 0), cB, voffB); PG8_STAGE(PG8_SB(0, 1), cB + hstep, voffB); PG8_STAGE(PG8_SA(0, 0), cA, voffA); PG8_STAGE(PG8_SA(0, 1), cA + hstep, voffA);
        if (wr == 1) PG8_BAR;
        PG8_WAIT_V(2); PG8_BAR;
        PG8_STAGE(PG8_SB(1, 0), cB + kstep, voffB); PG8_STAGE(PG8_SA(1, 0), cA + kstep, voffA); PG8_STAGE(PG8_SB(1, 1), cB + hstep + kstep, voffB);
        PG8_WAIT_V(6); PG8_BAR;
    } else {
        PG8_STAGE(PG8_SB(0, 0), cB, voffB); PG8_STAGE(PG8_SA(0, 0), cA, voffA); PG8_STAGE(PG8_SB(0, 1), cB + hstep, voffB); PG8_STAGE(PG8_SA(0, 1), cA + hstep, voffA);
        if (wr == 1) PG8_BAR;
        PG8_WAIT_V(4); PG8_BAR;
        PG8_STAGE(PG8_SB(1, 0), cB + kstep, voffB); PG8_STAGE(PG8_SA(1, 0), cA + kstep, voffA); PG8_STAGE(PG8_SB(1, 1), cB + hstep + kstep, voffB);
        PG8_WAIT_V(6); PG8_BAR;
    }
    for (;;) {
        const bool has_next = S.next(ui + 1, nxt);
        const char* nA = has_next ? (const char*)g.A + (size_t)nxt.pm * tstep : cA; const char* nB = has_next ? (const char*)g.Bt + (size_t)nxt.pn * tstep : cB;
        for (int t = 0; t < nt; t += 2) {
            const bool last = (t == nt - 2);
            const char* a1 = cA + (size_t)(t + 1) * kstep;
            const char* a2 = last ? nA : cA + (size_t)(t + 2) * kstep; const char* b2 = last ? nB : cB + (size_t)(t + 2) * kstep;
            const char* a3 = a2 + kstep; const char* b3 = b2 + kstep;
            if (last && has_next) S.a_ready(nxt);
            if constexpr (SP2) {
            PG8_LDB(B0, 0, 0); PG8_LDB(B1, 0, 1); PG8_SCHED; PG8_LDA(At, 0, 0); PG8_STAGE(PG8_SA(1, 1), a1 + hstep, voffA);
            PG8_WAIT_V(8); PG8_WAIT_L(0); PG8_BAR; PG8_MMA(0, 0, At, B0); PG8_MMA(0, 1, At, B1); PG8_BAR; PG8_SCHED;
            PG8_LDA(At, 0, 1); PG8_STAGE(PG8_SB(0, 0), b2, voffB); PG8_STAGE(PG8_SB(0, 1), b2 + hstep, voffB); PG8_STAGE(PG8_SA(0, 0), a2, voffA);
            PG8_WAIT_V(8); PG8_WAIT_L(0); PG8_BAR; PG8_MMA(1, 0, At, B0); PG8_MMA(1, 1, At, B1); PG8_BAR; PG8_SCHED;
            PG8_LDB(B0, 1, 0); PG8_LDB(B1, 1, 1); PG8_SCHED; PG8_LDA(At, 1, 0); PG8_STAGE(PG8_SA(0, 1), a2 + hstep, voffA);
            PG8_WAIT_V(8); PG8_WAIT_L(0); PG8_BAR; PG8_MMA(0, 0, At, B0); PG8_MMA(0, 1, At, B1); PG8_BAR; PG8_SCHED;
            PG8_LDA(At, 1, 1); PG8_STAGE(PG8_SB(1, 0), b3, voffB); PG8_STAGE(PG8_SB(1, 1), b3 + hstep, voffB); PG8_STAGE(PG8_SA(1, 0), a3, voffA);
            PG8_WAIT_V(8); PG8_WAIT_L(0); PG8_BAR; PG8_MMA(1, 0, At, B0); PG8_MMA(1, 1, At, B1); PG8_BAR; PG8_SCHED;
            } else {
            PG8_LDB(B0, 0, 0); PG8_SCHED; PG8_LDA(At, 0, 0); PG8_STAGE(PG8_SA(1, 1), a1 + hstep, voffA);
            PG8_WAIT_L(8); PG8_BAR; PG8_WAIT_L(0); PG8_MMA(0, 0, At, B0); PG8_BAR; PG8_SCHED;
            PG8_LDB(B1, 0, 1); PG8_STAGE(PG8_SB(0, 0), b2, voffB);
            PG8_BAR; PG8_WAIT_L(0); PG8_MMA(0, 1, At, B1); PG8_BAR;
            PG8_LDA(At, 0, 1); PG8_STAGE(PG8_SA(0, 0), a2, voffA);
            PG8_BAR; PG8_WAIT_L(0); PG8_MMA(1, 0, At, B0); PG8_BAR; PG8_SCHED;
            PG8_STAGE(PG8_SB(0, 1), b2 + hstep, voffB);
            PG8_WAIT_V(6); PG8_BAR; PG8_MMA(1, 1, At, B1); PG8_BAR;
            PG8_LDB(B0, 1, 0); PG8_SCHED; PG8_LDA(At, 1, 0); PG8_STAGE(PG8_SA(0, 1), a2 + hstep, voffA);
            PG8_WAIT_L(8); PG8_BAR; PG8_WAIT_L(0); PG8_MMA(0, 0, At, B0); PG8_BAR; PG8_SCHED;
            PG8_LDB(B1, 1, 1); PG8_STAGE(PG8_SB(1, 0), b3, voffB);
            PG8_BAR; PG8_WAIT_L(0); PG8_MMA(0, 1, At, B1); PG8_BAR;
            PG8_LDA(At, 1, 1); PG8_STAGE(PG8_SA(1, 0), a3, voffA);
            PG8_BAR; PG8_WAIT_L(0); PG8_MMA(1, 0, At, B0); PG8_BAR; PG8_SCHED;
            PG8_STAGE(PG8_SB(1, 1), b3 + hstep, voffB);
            PG8_WAIT_V(6); PG8_BAR; PG8_MMA(1, 1, At, B1); PG8_BAR;
            }
            if constexpr (Epi::MIDK) { if (t + 2 == (nt >> 1)) E.mid(acc, cur, wr, wc, fr, fq); }
        }
        if constexpr (ALIGN_EPI) { if (wr == 0) PG8_BAR; }
        if constexpr (!Epi::AFTER_DRAIN) { E(acc, cur, wr, wc, fr, fq); S.done(cur); }
        if (!has_next) break;
#pragma unroll
        for (int a = 0; a < 2; ++a)
#pragma unroll
            for (int b = 0; b < 2; ++b)
#pragma unroll
                for (int m = 0; m < 4; ++m)
#pragma unroll
                    for (int n = 0; n < 2; ++n) acc[a][b][m][n] = (f32x4){0.f, 0.f, 0.f, 0.f};
        cur = nxt; cA = nA; cB = nB; ++ui;
        if constexpr (ALIGN_EPI) { if (wr == 1) PG8_BAR; }
    }
    PG8_WAIT_V(0);
    if constexpr (!ALIGN_EPI) { if (wr == 0) PG8_BAR; }
    PG8_BAR;
    if constexpr (Epi::AFTER_DRAIN) { E.fused(acc, cur, wr, wc, fr, fq, lds, wid, lane); S.done(cur); }
#undef PG8_SA
#undef PG8_SB
#undef PG8_STAGE
#undef PG8_LDA
#undef PG8_LDB
#undef PG8_MMA
#undef PG8_WAIT_V
#undef PG8_WAIT_L
#undef PG8_BAR
#undef PG8_SCHED
}
}

using pg8::Gemm;
__device__ __forceinline__ int fresh_lane() { int l; asm volatile("v_mbcnt_lo_u32_b32 %0, -1, 0\n\tv_mbcnt_hi_u32_b32 %0, -1, %0" : "=v"(l)); return l; }
#define LAS __attribute__((address_space(3)))

constexpr size_t MiB = 1u << 20;
constexpr size_t WS_CTL = 0;
constexpr size_t WS_WIN = 1 * MiB;
constexpr size_t WS_WOUT = WS_WIN + (size_t)DIN * D * 2;
constexpr size_t WS_WUG = WS_WOUT + (size_t)D * D * 2;
constexpr size_t WS_WDN = WS_WUG + (size_t)2 * DFF * D * 2;
constexpr size_t WS_R1 = WS_WDN + (size_t)D * DFF * 2;
constexpr size_t WS_H0 = WS_R1;
constexpr size_t WS_Z = WS_H0 + (size_t)MP * D * 2;
constexpr size_t WS_MIX = WS_Z + (size_t)MP * DIN * 2;
constexpr size_t WS_ACT = WS_R1;
constexpr size_t WS_R1_END = WS_MIX + (size_t)MP * D * 2;
constexpr size_t WS_X1B = WS_R1_END;
constexpr size_t WS_XS = WS_X1B + (size_t)MP * D * 2;
constexpr size_t WS_SSA = WS_XS + (size_t)64 * D * 4;
constexpr size_t WS_RS1 = WS_SSA + (size_t)MP * 4;
constexpr size_t WS_HALO = WS_RS1 + (size_t)MP * 4;
constexpr size_t WS_FIRST = WS_HALO + (size_t)129 * 2 * DFF * 4;
constexpr size_t WS_END = WS_FIRST + (size_t)128 * 4 * DFF * 4;
constexpr size_t WS_GWF = WS_FIRST;
constexpr size_t WS_SUMA = WS_GWF + (size_t)16384 * 16;
constexpr size_t WS_SUMB = WS_SUMA + (size_t)65 * 1024 * 4;
constexpr size_t WS_SUMHA = WS_SUMB + (size_t)65 * 1024 * 4;
constexpr size_t WS_SUMHB = WS_SUMHA + (size_t)129 * 1024 * 4;
static_assert(WS_SUMHB + (size_t)129 * 1024 * 4 <= WS_END, "scan scratch fits inside first[]");
static_assert(WS_ACT + (size_t)MP * DFF * 2 <= WS_R1_END, "ACT overlay fits in H0|Z|MIX");
static_assert(WS_END <= 308053024, "workspace map must fit the guaranteed d_ws size");


namespace cg = cooperative_groups;
struct Params {
    const float *x_prompt, *x_sample, *st_conv, *st_h, *cache_k, *cache_v, *st_ffn, *meta, *table, *norm_mix, *w_in, *conv_w, *conv_b, *ga_w, *ga_b, *gx_w, *gx_b, *lam, *sinks,
                *norm_rnn, *norm_attn, *w_out, *norm_ffn, *w_up, *w_gate, *fconv_w, *fconv_b, *w_down, *norm_final;
    float* out; unsigned char* ws;
};
__device__ __forceinline__ void prep_row(const XIn& X, bf16_t* H0, int row, int lane) {
    u32x2* o = (u32x2*)(H0 + (size_t)row * D) + lane;
    const float* src = xin_ptr(X, row);
    if (!src) {
#pragma unroll
        for (int j = 0; j < 8; ++j) o[64 * j] = (u32x2){0u, 0u};
        return;
    }
    const f32x4* xr = (const f32x4*)src + lane;
    f32x4 v[8]; float s = 0.f;
#pragma unroll
    for (int j = 0; j < 8; ++j) { v[j] = xr[64 * j]; s += (v[j].x * v[j].x + v[j].y * v[j].y) + (v[j].z * v[j].z + v[j].w * v[j].w); }
    const float rs = 1.0f / sqrtf(wave_sum(s) * (1.0f / D) + EPS);
#pragma unroll
    for (int j = 0; j < 8; ++j) o[64 * j] = (u32x2){pk2(v[j].x * rs, v[j].y * rs), pk2(v[j].z * rs, v[j].w * rs)};
}
__device__ __forceinline__ void mixnorm_row(const RowMap& R, bf16_t* MIX, int row, int lane) {
    const f32x4* y = (const f32x4*)xrow_ptr(R, row) + lane;
    f32x4 v[8]; float s0 = 0.f, s1 = 0.f;
#pragma unroll
    for (int j = 0; j < 8; ++j) { v[j] = y[64 * j]; const float q = (v[j].x * v[j].x + v[j].y * v[j].y) + (v[j].z * v[j].z + v[j].w * v[j].w); if (j < 4) s0 += q; else s1 += q; }
    const float r0 = 1.0f / sqrtf(wave_sum(s0) * (1.0f / DRNN) + EPS), r1 = 1.0f / sqrtf(wave_sum(s1) * (1.0f / DATT) + EPS);
    u32x2* o = (u32x2*)(MIX + (size_t)row * D) + lane;
#pragma unroll
    for (int j = 0; j < 8; ++j) { const float r = j < 4 ? r0 : r1; o[64 * j] = (u32x2){pk2(v[j].x * r, v[j].y * r), pk2(v[j].z * r, v[j].w * r)}; }
}
__device__ __forceinline__ void x1b_row(const RowMap& R, bf16_t* X1b, float* rs1, int row, int lane) {
    const f32x4* y = (const f32x4*)xrow_ptr(R, row) + lane;
    f32x4 v[8]; float s = 0.f;
#pragma unroll
    for (int j = 0; j < 8; ++j) { v[j] = y[64 * j]; s += (v[j].x * v[j].x + v[j].y * v[j].y) + (v[j].z * v[j].z + v[j].w * v[j].w); }
    s = wave_sum(s);
    if (lane == 0) rs1[row] = 1.0f / sqrtf(s * (1.0f / D) + EPS);
    u32x2* o = (u32x2*)(X1b + (size_t)row * D) + lane;
#pragma unroll
    for (int j = 0; j < 8; ++j) o[64 * j] = (u32x2){pk2(v[j].x, v[j].y), pk2(v[j].z, v[j].w)};
}
__device__ __forceinline__ void final_row(float* out, const float* gfin, int r, int lane) {
    f32x4* y = (f32x4*)(out + (r < NBIG ? O_Y + (size_t)r * D : O_YS + (size_t)(r - NBIG) * D)) + lane;
    const f32x4* g = (const f32x4*)gfin + lane;
    f32x4 v[8]; float s = 0.f;
#pragma unroll
    for (int j = 0; j < 8; ++j) { v[j] = y[64 * j]; s += (v[j].x * v[j].x + v[j].y * v[j].y) + (v[j].z * v[j].z + v[j].w * v[j].w); }
    const float rs = 1.0f / sqrtf(wave_sum(s) * (1.0f / D) + EPS);
#pragma unroll
    for (int j = 0; j < 8; ++j) y[64 * j] = v[j] * rs * g[64 * j];
}
struct WPrep { const float *w_in, *w_out, *w_up, *w_gate, *w_down, *g_mix, *g_rnn, *g_attn, *g_ffn; bf16_t *t_in, *t_out, *t_ug, *t_dn; };
constexpr int WT_IN = (D / 64) * (DIN / 64), WT_OUT = (D / 64) * (D / 64), WT_UP = (D / 64) * (DFF / 64), WT_DN = (DFF / 64) * (D / 64);
constexpr int WT_TOTAL = WT_IN + WT_OUT + 2 * WT_UP + WT_DN;
static_assert(WT_TOTAL % 2 == 0, "two tiles per block iteration");
struct WTile { const float* src; bf16_t* dst; int N, K, job, k0, n0; };
__device__ __forceinline__ WTile wprep_decode(const WPrep& P, int it) {
    WTile t;
    if (it < WT_IN) { t.job = 0; t.src = P.w_in; t.dst = P.t_in; t.K = D; t.N = DIN; }
    else if ((it -= WT_IN) < WT_OUT) { t.job = 1; t.src = P.w_out; t.dst = P.t_out; t.K = D; t.N = D; }
    else if ((it -= WT_OUT) < WT_UP) { t.job = 2; t.src = P.w_up; t.dst = P.t_ug; t.K = D; t.N = DFF; }
    else if ((it -= WT_UP) < WT_UP) { t.job = 3; t.src = P.w_gate; t.dst = P.t_ug; t.K = D; t.N = DFF; }
    else { it -= WT_UP; t.job = 4; t.src = P.w_down; t.dst = P.t_dn; t.K = DFF; t.N = D; }
    const int nblk = t.N / 64; t.k0 = (it / nblk) * 64; t.n0 = (it % nblk) * 64;
    return t;
}
__device__ __forceinline__ void wprep_load(const WTile& t, int tid, f32x4 (&v)[4]) {
    const float* p = t.src + (size_t)(t.k0 + (tid >> 4)) * t.N + t.n0 + 4 * (tid & 15);
#pragma unroll
    for (int i = 0; i < 4; ++i) v[i] = *(const f32x4*)(p + (size_t)(16 * i) * t.N);
}
__device__ __forceinline__ void wprep_store(const WPrep& P, const WTile& t, int tid, const f32x4 (&v)[4], LAS float* s  ) {
#pragma unroll
    for (int i = 0; i < 4; ++i) {
        const int kk = (tid >> 4) + 16 * i, k = t.k0 + kk;
        float g = 1.0f;
        if (t.job == 0) g = P.g_mix[k]; else if (t.job == 1) g = k < DRNN ? P.g_rnn[k] : P.g_attn[k - DRNN]; else if (t.job == 2 || t.job == 3) g = P.g_ffn[k];
        LAS float* sp = s + kk * 65 + 4 * (tid & 15);
        sp[0] = v[i].x * g; sp[1] = v[i].y * g; sp[2] = v[i].z * g; sp[3] = v[i].w * g;
    }
    __syncthreads();
#pragma unroll
    for (int h = 0; h < 2; ++h) {
        const int n = tid >> 2, c = (tid & 3) + 4 * h, ng = t.n0 + n;
        int drow = ng;
        if (t.job == 2) drow = 256 * (ng >> 7) + (ng & 127); else if (t.job == 3) drow = 256 * (ng >> 7) + 128 + (ng & 127);
        const LAS float* sp = s + (8 * c) * 65 + n;
        u32x4 o; o.x = pk2(sp[0], sp[65]); o.y = pk2(sp[2 * 65], sp[3 * 65]); o.z = pk2(sp[4 * 65], sp[5 * 65]); o.w = pk2(sp[6 * 65], sp[7 * 65]);
        const int kd = t.job == 1 ? ((t.k0 + DRNN) & (D - 1)) : t.k0;
        *(u32x4*)(t.dst + (size_t)drow * t.K + kd + 8 * c) = o;
    }
    __syncthreads();
}
__device__ __forceinline__ int rel_bucket(int d) {
    if (d < 16) return d;
    const int l = 16 + (int)(logf((float)d * (1.0f / 16.0f)) / 2.0794415417f * 16.0f);
    return l < 31 ? l : 31;
}

typedef short bf16x8 __attribute__((ext_vector_type(8)));
typedef float f32x16 __attribute__((ext_vector_type(16)));
constexpr int NCHUNK = 65;
struct ScanIn {
    const bf16_t* Z; RowMap R; bf16_t* MIX;
    const float *st_conv, *st_h, *conv_w, *conv_b, *ga_b, *gx_b, *lam;
    const u32x4* gwf;
    float *sumA, *sumB;
    float *sumHA, *sumHB;
    bf16_t *oma, *bb;
    float* out;
};
__device__ __forceinline__ void prep_gwf_frag(const float* ga_w, const float* gx_w, u32x4* gwf, int i) {
    const int lane = i & 63, s = (i >> 6) & 3, nb = (i >> 8) & 1, gate = (i >> 9) & 1, blk = i >> 10;
    const float* W = (gate ? gx_w : ga_w) + (size_t)blk * 64 * 64;
    const int n = 32 * nb + (lane & 31), k0 = 16 * s + 8 * (lane >> 5);
    u32x4 o; o.x = pk2(W[(k0 + 0) * 64 + n], W[(k0 + 1) * 64 + n]); o.y = pk2(W[(k0 + 2) * 64 + n], W[(k0 + 3) * 64 + n]);
    o.z = pk2(W[(k0 + 4) * 64 + n], W[(k0 + 5) * 64 + n]); o.w = pk2(W[(k0 + 6) * 64 + n], W[(k0 + 7) * 64 + n]);
    gwf[i] = o;
}
__device__ __forceinline__ float bflo(unsigned w) { return __uint_as_float(w << 16); }
__device__ __forceinline__ float bfhi(unsigned w) { return __uint_as_float(w & 0xffff0000u); }

template <int MODE>
__device__ __forceinline__ void gate_preact(const ScanIn& S, int blk, int t0, int b0, int lane, f32x16& pa0, f32x16& pa1, f32x16& px0, f32x16& px1) {
    const int tt = lane & 31, hh = lane >> 5;
    f32x16 aa0 = {}, aa1 = {}, ax0 = {}, ax1 = {};
#pragma unroll 1
    for (int s = 0; s < 4; ++s) {
        const int ch = 64 * blk + 16 * s + 8 * hh;
        float xc[8];
        { const f32x4 c0 = *(const f32x4*)(S.conv_b + ch), c1 = *(const f32x4*)(S.conv_b + ch + 4);
#pragma unroll
          for (int e = 0; e < 4; ++e) { xc[e] = c0[e]; xc[4 + e] = c1[e]; } }
#pragma unroll
        for (int j = 0; j < 4; ++j) {
            const f32x4 w0 = *(const f32x4*)(S.conv_w + j * DRNN + ch), w1 = *(const f32x4*)(S.conv_w + j * DRNN + ch + 4);
            float xv[8];
            if (MODE == 2 && j < 3) {
                const float* sp = S.st_conv + ((size_t)(b0 + tt) * 3 + j) * DRNN + ch;
                const f32x4 a = *(const f32x4*)sp, b = *(const f32x4*)(sp + 4);
#pragma unroll
                for (int e = 0; e < 4; ++e) { xv[e] = a[e]; xv[4 + e] = b[e]; }
            } else {
                const int t = t0 + tt - 3 + j;
                const int row = MODE == 2 ? ROW_SAMP + b0 + tt : tok2row(t < 0 ? 0 : t);
                u32x4 q = *(const u32x4*)(S.Z + (size_t)row * DIN + ZC_XR + ch);
                if (MODE != 2 && t < 0) q = (u32x4){0u, 0u, 0u, 0u};
                xv[0] = bflo(q.x); xv[1] = bfhi(q.x); xv[2] = bflo(q.y); xv[3] = bfhi(q.y); xv[4] = bflo(q.z); xv[5] = bfhi(q.z); xv[6] = bflo(q.w); xv[7] = bfhi(q.w);
            }
#pragma unroll
            for (int e = 0; e < 4; ++e) { xc[e] += w0[e] * xv[e]; xc[4 + e] += w1[e] * xv[4 + e]; }
        }
        u32x4 ap; ap.x = pk2(xc[0], xc[1]); ap.y = pk2(xc[2], xc[3]); ap.z = pk2(xc[4], xc[5]); ap.w = pk2(xc[6], xc[7]);
        const bf16x8 A = __builtin_bit_cast(bf16x8, ap);
        const u32x4* g = S.gwf + ((size_t)(blk * 2) * 2 * 4 + s) * 64 + lane;
        const bf16x8 Ba0 = __builtin_bit_cast(bf16x8, g[0]), Ba1 = __builtin_bit_cast(bf16x8, g[4 * 64]), Bx0 = __builtin_bit_cast(bf16x8, g[8 * 64]), Bx1 = __builtin_bit_cast(bf16x8, g[12 * 64]);
        aa0 = __builtin_amdgcn_mfma_f32_32x32x16_bf16(A, Ba0, aa0, 0, 0, 0);
        aa1 = __builtin_amdgcn_mfma_f32_32x32x16_bf16(A, Ba1, aa1, 0, 0, 0);
        ax0 = __builtin_amdgcn_mfma_f32_32x32x16_bf16(A, Bx0, ax0, 0, 0, 0);
        ax1 = __builtin_amdgcn_mfma_f32_32x32x16_bf16(A, Bx1, ax1, 0, 0, 0);
    }
#pragma unroll
    for (int i = 0; i < 16; ++i) {
        auto r = __builtin_amdgcn_permlane32_swap(__float_as_uint(aa0[i]), __float_as_uint(aa1[i]), false, false);
        pa0[i] = __uint_as_float(r[0]); pa1[i] = __uint_as_float(r[1]);
        auto q = __builtin_amdgcn_permlane32_swap(__float_as_uint(ax0[i]), __float_as_uint(ax1[i]), false, false);
        px0[i] = __uint_as_float(q[0]); px1[i] = __uint_as_float(q[1]);
    }
}

struct ChanConst { float cw0, cw1, cw2, cw3, cb, ba, bx, csp; };
__device__ __forceinline__ ChanConst chan_const(const ScanIn& S, int c) {
    ChanConst k; k.cw0 = S.conv_w[c]; k.cw1 = S.conv_w[DRNN + c]; k.cw2 = S.conv_w[2 * DRNN + c]; k.cw3 = S.conv_w[3 * DRNN + c]; k.cb = S.conv_b[c];
    k.ba = S.ga_b[c]; k.bx = S.gx_b[c];
    const float lam = S.lam[c];
    k.csp = 8.0f * (fmaxf(-lam, 0.f) + log1pf(expf(-fabsf(lam))));
    return k;
}
__device__ __forceinline__ void lru_ab(const ChanConst& k, float pa, float px, float xc, float& oma, float& b) {
    const float r = sigmoid_f(pa + k.ba), ig = sigmoid_f(px + k.bx);
    const float a = __builtin_amdgcn_exp2f(k.csp * r * (-1.4426950409f));
    oma = 1.0f - a;
    b = __builtin_amdgcn_sqrtf(oma * (1.0f + a)) * ig * xc;
}
__device__ __forceinline__ void rglru_passA(const ScanIn& S, int k, int hfc, int wave, int lane) {
    const int blk = 8 * hfc + wave, c = 64 * blk + lane;
    const int nsub = k == 0 ? 1 : 4, tbase = k == 0 ? 0 : 16 + 128 * (k - 1), nv = k == 0 ? 16 : 32;
    const ChanConst kc = chan_const(S, c);
    float x3 = tbase - 3 >= 0 ? bf2f(S.Z[(size_t)tok2row(tbase - 3) * DIN + ZC_XR + c]) : 0.f;
    float x2 = tbase - 2 >= 0 ? bf2f(S.Z[(size_t)tok2row(tbase - 2) * DIN + ZC_XR + c]) : 0.f;
    float x1 = tbase - 1 >= 0 ? bf2f(S.Z[(size_t)tok2row(tbase - 1) * DIN + ZC_XR + c]) : 0.f;
    float P = 1.f, hl = 0.f, P0 = 1.f, hl0 = 0.f;
    for (int sc = 0; sc < nsub; ++sc) {
        if (sc == 2) { P0 = P; hl0 = hl; P = 1.f; hl = 0.f; }
        const int t0 = tbase + 32 * sc, row0 = tok2row(t0);
        f32x16 pa0, pa1, px0, px1;
        gate_preact<0>(S, blk, t0, 0, lane, pa0, pa1, px0, px1);
        const bf16_t* zp = S.Z + (size_t)row0 * DIN + ZC_XR + c;
        bf16_t* op = S.oma + (size_t)row0 * DRNN + c; bf16_t* bp = S.bb + (size_t)row0 * DRNN + c;
#pragma unroll
        for (int q = 0; q < 2; ++q) {
            float xr[16];
#pragma unroll
            for (int i = 0; i < 16; ++i) xr[i] = bf2f(zp[(size_t)(16 * q + i) * DIN]);
#pragma unroll
            for (int i = 0; i < 16; ++i) {
                const int tt = 16 * q + i;
                if (tt < nv) {
                    const int g = tt >> 3, hh = (tt >> 2) & 1, j = tt & 3;
                    const float pa = hh ? pa1[4 * g + j] : pa0[4 * g + j], px = hh ? px1[4 * g + j] : px0[4 * g + j];
                    const float xc = kc.cb + kc.cw0 * x3 + kc.cw1 * x2 + kc.cw2 * x1 + kc.cw3 * xr[i];
                    x3 = x2; x2 = x1; x1 = xr[i];
                    float oma, b; lru_ab(kc, pa, px, xc, oma, b);
                    const unsigned ob = f2bf(oma), bbits = f2bf(b);
                    op[(size_t)tt * DRNN] = (bf16_t)ob; bp[(size_t)tt * DRNN] = (bf16_t)bbits;
                    const float ar = 1.0f - __uint_as_float(ob << 16), br = __uint_as_float(bbits << 16);
                    P *= ar; hl = ar * hl + br;
                }
            }
            asm volatile("" ::: "memory");
        }
    }
    if (k == 0) { S.sumHA[c] = P; S.sumHB[c] = hl; S.sumA[c] = P; S.sumB[c] = hl; }
    else {
        const size_t h0 = (size_t)(1 + 2 * (k - 1)) * DRNN + c;
        S.sumHA[h0] = P0; S.sumHB[h0] = hl0; S.sumHA[h0 + DRNN] = P; S.sumHB[h0 + DRNN] = hl;
        S.sumA[(size_t)k * DRNN + c] = P0 * P; S.sumB[(size_t)k * DRNN + c] = P * hl0 + hl;
    }
}
template <class RowOf>
__device__ __forceinline__ void ytile_store(bf16_t* MIX, LAS unsigned char* lds, int wave, int lane, RowOf rowof) {
#pragma unroll
    for (int i = 0; i < 4; ++i) {
        const int tt = 4 * wave + i, row = rowof(tt);
        if (row < 0) continue;
        const LAS f32x4* yp = (const LAS f32x4*)(lds + (size_t)tt * 4096) + lane;
        f32x4 v[4]; float ss = 0.f;
#pragma unroll
        for (int j = 0; j < 4; ++j) { v[j] = yp[64 * j]; ss += (v[j].x * v[j].x + v[j].y * v[j].y) + (v[j].z * v[j].z + v[j].w * v[j].w); }
        const float rs = 1.0f / sqrtf(wave_sum(ss) * (1.0f / DRNN) + EPS);
        u32x2* o = (u32x2*)(MIX + (size_t)row * D + DRNN) + lane;
#pragma unroll
        for (int j = 0; j < 4; ++j) o[64 * j] = (u32x2){pk2(v[j].x * rs, v[j].y * rs), pk2(v[j].z * rs, v[j].w * rs)};
    }
}
__device__ __forceinline__ void rglru_passB(const ScanIn& S, LAS unsigned char* lds, int hidx, int wave, int lane) {
    const int k = hidx == 0 ? 0 : 1 + ((hidx - 1) >> 1), hf = hidx == 0 ? 0 : (hidx - 1) & 1;
    const int nsub = hidx == 0 ? 1 : 2, tf = hidx == 0 ? 0 : 16 + 128 * (k - 1) + 64 * hf, nv = hidx == 0 ? 16 : 32;
    const int c0 = 128 * wave + 2 * lane;
    float h0 = 0.f, h1 = 0.f;
    for (int k0 = 0; k0 < k; k0 += 8) {
        f32x2 A[8], B[8];
#pragma unroll
        for (int u = 0; u < 8; ++u) { const int kk = k0 + u < k ? k0 + u : k - 1; A[u] = *(const f32x2*)(S.sumA + (size_t)kk * DRNN + c0); B[u] = *(const f32x2*)(S.sumB + (size_t)kk * DRNN + c0); }
#pragma unroll
        for (int u = 0; u < 8; ++u) { const bool v = k0 + u < k; h0 = (v ? A[u].x : 1.f) * h0 + (v ? B[u].x : 0.f); h1 = (v ? A[u].y : 1.f) * h1 + (v ? B[u].y : 0.f); }
    }
    if (hf) { const f32x2 A = *(const f32x2*)(S.sumHA + (size_t)(hidx - 1) * DRNN + c0), B = *(const f32x2*)(S.sumHB + (size_t)(hidx - 1) * DRNN + c0); h0 = A.x * h0 + B.x; h1 = A.y * h1 + B.y; }
    for (int s2 = 0; s2 < nsub; ++s2) {
        const int t0 = tf + 32 * s2, row0 = tok2row(t0);
        const bf16_t* op = S.oma + (size_t)row0 * DRNN + c0; const bf16_t* bp = S.bb + (size_t)row0 * DRNN + c0; const bf16_t* gp = S.Z + (size_t)row0 * DIN + ZC_GR + c0;
#pragma unroll
        for (int q = 0; q < 4; ++q) {
            unsigned wo[8], wb[8], wg[8];
#pragma unroll
            for (int i = 0; i < 8; ++i) { const int tt = 8 * q + i; wo[i] = *(const unsigned*)(op + (size_t)tt * DRNN); wb[i] = *(const unsigned*)(bp + (size_t)tt * DRNN); wg[i] = *(const unsigned*)(gp + (size_t)tt * DIN); }
#pragma unroll
            for (int i = 0; i < 8; ++i) {
                const int tt = 8 * q + i;
                if (tt < nv) {
                    h0 = h0 - bflo(wo[i]) * h0 + bflo(wb[i]); h1 = h1 - bfhi(wo[i]) * h1 + bfhi(wb[i]);
                    *(LAS f32x2*)(lds + (size_t)tt * 4096 + c0 * 4) = (f32x2){h0 * gelu_tanh(bflo(wg[i])), h1 * gelu_tanh(bfhi(wg[i]))};
                }
            }
            asm volatile("" ::: "memory");
        }
        __syncthreads();
        ytile_store(S.MIX, lds, wave, lane, [&](int tt) { return tt < nv ? row0 + tt : -1; });
        __syncthreads();
    }
    if (hidx == 128) { const int l2 = fresh_lane(); *(f32x2*)(S.out + O_PRH + 128 * wave + 2 * l2) = (f32x2){h0, h1}; }
}
__device__ __forceinline__ void rglru_sample_out(const ScanIn& S, LAS unsigned char* lds, int sb, int wave, int lane) {
    const int b0 = 32 * sb;
#pragma unroll
    for (int hb = 0; hb < 2; ++hb) {
        const int blk = 2 * wave + hb, c = 64 * blk + lane;
        const ChanConst kc = chan_const(S, c);
        f32x16 pa0, pa1, px0, px1;
        gate_preact<2>(S, blk, 0, b0, lane, pa0, pa1, px0, px1);
        const float* stp = S.st_conv + (size_t)b0 * 3 * DRNN + c; const float* hp = S.st_h + (size_t)b0 * DRNN + c;
        const bf16_t* zp = S.Z + (size_t)(ROW_SAMP + b0) * DIN + c;
        float* ohp = S.out + O_SRH + (size_t)b0 * DRNN + c; float* ocp = S.out + O_SRC + (size_t)b0 * 3 * DRNN + c;
#pragma unroll
        for (int tt = 0; tt < 32; ++tt) {
            const int g = tt >> 3, hh = (tt >> 2) & 1, j = tt & 3;
            const float pa = hh ? pa1[4 * g + j] : pa0[4 * g + j], px = hh ? px1[4 * g + j] : px0[4 * g + j];
            const float s0 = stp[0], s1 = stp[DRNN], s2 = stp[2 * DRNN];
            const float xn = bf2f(zp[ZC_XR]), gr = bf2f(zp[ZC_GR]);
            const float xc = kc.cb + kc.cw0 * s0 + kc.cw1 * s1 + kc.cw2 * s2 + kc.cw3 * xn;
            float oma, bb; lru_ab(kc, pa, px, xc, oma, bb);
            const float h0v = hp[0]; const float h = h0v - oma * h0v + bb;
            *(LAS float*)(lds + (size_t)tt * 4096 + c * 4) = h * gelu_tanh(gr);
            ohp[0] = h;
            ocp[0] = s1; ocp[DRNN] = s2; ocp[2 * DRNN] = xn;
            stp += 3 * DRNN; hp += DRNN; zp += DIN; ohp += DRNN; ocp += 3 * DRNN;
            asm volatile("" : "+v"(stp), "+v"(hp), "+v"(zp), "+v"(ohp), "+v"(ocp));
        }
    }
    __syncthreads();
    ytile_store(S.MIX, lds, wave, lane, [&](int tt) { return ROW_SAMP + b0 + tt; });
    __syncthreads();
}

constexpr int AT_K_OFF = 0, AT_VT_OFF = 49152, AT_VT_STRIDE = 392, AT_BIAS_OFF = AT_VT_OFF + 128 * AT_VT_STRIDE  , AT_LDS = AT_BIAS_OFF + 2048;
constexpr int N_QB = 129;
constexpr float ATT_SCALE = 0.08838834764831845f;
struct AttnIn { const bf16_t* Z; bf16_t* MIX; float* ssa; const float *cache_k, *cache_v, *sinks, *table; float* out; };

__device__ __forceinline__ void attn_prompt_unit(const AttnIn& A, LAS unsigned char* lds, int kvh, int qb, int tid) {
    const int wave = __builtin_amdgcn_readfirstlane(tid >> 6), lane = tid & 63, g = wave >> 1, qh = wave & 1, h = 4 * kvh + g;
    const int ql = lane & 31, hh = lane >> 5;
    const int tk0 = 64 * qb - 128;
#pragma unroll
    for (int i = 0; i < 6; ++i) {
        const int id = tid + 512 * i, key = id >> 4, c = id & 15, tk = tk0 + key;
        u32x4 kq = (u32x4){0u, 0u, 0u, 0u}, vq = (u32x4){0u, 0u, 0u, 0u};
        if (tk >= 0 && tk < TP) {
            const bf16_t* zr = A.Z + (size_t)tok2row(tk) * DIN + kvh * HD + 8 * c;
            kq = *(const u32x4*)(zr + ZC_K); vq = *(const u32x4*)(zr + ZC_V);
        }
        *(LAS u32x4*)(lds + AT_K_OFF + key * 256 + ((c ^ (key & 15)) << 4)) = kq;
        LAS unsigned short* vt = (LAS unsigned short*)(lds + AT_VT_OFF + (8 * c) * AT_VT_STRIDE + 2 * key);
        vt[0 * (AT_VT_STRIDE / 2)] = (unsigned short)(vq.x & 0xffffu); vt[1 * (AT_VT_STRIDE / 2)] = (unsigned short)(vq.x >> 16);
        vt[2 * (AT_VT_STRIDE / 2)] = (unsigned short)(vq.y & 0xffffu); vt[3 * (AT_VT_STRIDE / 2)] = (unsigned short)(vq.y >> 16);
        vt[4 * (AT_VT_STRIDE / 2)] = (unsigned short)(vq.z & 0xffffu); vt[5 * (AT_VT_STRIDE / 2)] = (unsigned short)(vq.z >> 16);
        vt[6 * (AT_VT_STRIDE / 2)] = (unsigned short)(vq.w & 0xffffu); vt[7 * (AT_VT_STRIDE / 2)] = (unsigned short)(vq.w >> 16);
    }
    { const int gg = tid >> 7, dist = tid & 127; ((LAS float*)(lds + AT_BIAS_OFF))[tid] = A.table[rel_bucket(dist) * NH + 4 * kvh + gg]; }
    const int tq = 64 * qb + 32 * qh + ql;
    bf16x8 bq[8];
    { const bf16_t* qp = A.Z + (size_t)tok2row(tq < TP ? tq : TP - 1) * DIN + ZC_Q + h * HD + 8 * hh;
#pragma unroll
      for (int s = 0; s < 8; ++s) bq[s] = __builtin_bit_cast(bf16x8, *(const u32x4*)(qp + 16 * s)); }
    __syncthreads();
    f32x16 st[5];
#pragma unroll
    for (int kb = 0; kb < 5; ++kb) {
        const int kk = 32 * (qh + kb) + ql;
        f32x16 acc = {};
#pragma unroll
        for (int s = 0; s < 8; ++s) {
            const bf16x8 ka = __builtin_bit_cast(bf16x8, *(const LAS u32x4*)(lds + AT_K_OFF + kk * 256 + (((2 * s + hh) ^ (kk & 15)) << 4)));
            acc = __builtin_amdgcn_mfma_f32_32x32x16_bf16(ka, bq[s], acc, 0, 0, 0);
        }
        st[kb] = acc;
    }
    const LAS float* sb = (const LAS float*)(lds + AT_BIAS_OFF) + g * 128;
    const float sink = A.sinks[h];
    float mx = -1e30f;
#pragma unroll
    for (int kb = 0; kb < 5; ++kb)
#pragma unroll
        for (int i = 0; i < 16; ++i) {
            const int r = (i & 3) + 8 * (i >> 2) + 4 * hh;
            const int dist = 128 + ql - 32 * kb - r, tk = tk0 + 32 * (qh + kb) + r;
            const bool ok = dist >= 0 && dist < 128 && tk >= 0;
            const float l = ok ? st[kb][i] * ATT_SCALE + sb[dist & 127] : -1e30f;
            st[kb][i] = l; mx = fmaxf(mx, l);
        }
    mx = fmaxf(max_x32(mx), sink);
    float sum = 0.f;
#pragma unroll
    for (int kb = 0; kb < 5; ++kb)
#pragma unroll
        for (int i = 0; i < 16; ++i) { const float p = st[kb][i] > -1e29f ? __expf(st[kb][i] - mx) : 0.f; st[kb][i] = p; sum += p; }
    sum = sum_x32(sum);
    sum += __expf(sink - mx);
    const float inv = 1.0f / sum;
    const int orow = tok2row(tq < TP ? tq : TP - 1);
    float ssq = 0.f;
#pragma unroll
    for (int dh = 0; dh < 2; ++dh) {
        f32x16 ot[2] = {};
#pragma unroll
        for (int kb = 0; kb < 5; ++kb)
#pragma unroll
            for (int s2 = 0; s2 < 2; ++s2) {
                u32x4 pp; pp.x = pk2(st[kb][8 * s2 + 0], st[kb][8 * s2 + 1]); pp.y = pk2(st[kb][8 * s2 + 2], st[kb][8 * s2 + 3]);
                pp.z = pk2(st[kb][8 * s2 + 4], st[kb][8 * s2 + 5]); pp.w = pk2(st[kb][8 * s2 + 6], st[kb][8 * s2 + 7]);
                const bf16x8 pf = __builtin_bit_cast(bf16x8, pp);
                const int kk0 = 32 * (qh + kb) + 16 * s2 + 4 * hh;
#pragma unroll
                for (int d2 = 0; d2 < 2; ++d2) {
                    const LAS unsigned char* vp = lds + AT_VT_OFF + (32 * (2 * dh + d2) + ql) * AT_VT_STRIDE + 2 * kk0;
                    const u32x2 lo = *(const LAS u32x2*)vp, hi = *(const LAS u32x2*)(vp + 16);
                    const bf16x8 va = __builtin_bit_cast(bf16x8, (u32x4){lo.x, lo.y, hi.x, hi.y});
                    ot[d2] = __builtin_amdgcn_mfma_f32_32x32x16_bf16(va, pf, ot[d2], 0, 0, 0);
                }
            }
        bf16_t* y = A.MIX + (size_t)orow * D + h * HD + 4 * hh + 64 * dh;
#pragma unroll
        for (int d2 = 0; d2 < 2; ++d2)
#pragma unroll
            for (int g4 = 0; g4 < 4; ++g4) {
                const float v0 = ot[d2][4 * g4] * inv, v1 = ot[d2][4 * g4 + 1] * inv, v2 = ot[d2][4 * g4 + 2] * inv, v3 = ot[d2][4 * g4 + 3] * inv;
                ssq += (v0 * v0 + v1 * v1) + (v2 * v2 + v3 * v3);
                if (tq < TP) *(u32x2*)(y + 32 * d2 + 8 * g4) = (u32x2){pk2(v0, v1), pk2(v2, v3)};
            }
    }
    ssq = sum_x32(ssq);
    if (tq < TP && hh == 0) atomicAdd(A.ssa + orow, ssq);
    __syncthreads();
}

__device__ __forceinline__ void attn_sample_item(const AttnIn& A, LAS unsigned char* lds, int b, int kvh, int tid) {
    LAS float* sq = (LAS float*)lds;
    LAS float* sl = sq + 512;
    LAS float* so = sl + 512;
    const int row = ROW_SAMP + b, lane = tid & 63, wave = tid >> 6;
    { const int gg = tid >> 7, d = tid & 127; sq[tid] = bf2f(A.Z[(size_t)row * DIN + ZC_Q + (4 * kvh + gg) * HD + d]) * ATT_SCALE; }
    __syncthreads();
    {
        const int w = tid >> 2, part = tid & 3, d0 = 32 * part;
        float kv[32];
        if (w < 127) {
            const f32x4* kp = (const f32x4*)(A.cache_k + (((size_t)b * WIN + w + 1) * NKV + kvh) * HD + d0);
#pragma unroll
            for (int e = 0; e < 8; ++e) { const f32x4 v = kp[e]; kv[4 * e] = v.x; kv[4 * e + 1] = v.y; kv[4 * e + 2] = v.z; kv[4 * e + 3] = v.w; }
        } else {
            const u32x4* kp = (const u32x4*)(A.Z + (size_t)row * DIN + ZC_K + kvh * HD + d0);
#pragma unroll
            for (int e = 0; e < 4; ++e) { const u32x4 q = kp[e]; kv[8 * e] = bflo(q.x); kv[8 * e + 1] = bfhi(q.x); kv[8 * e + 2] = bflo(q.y); kv[8 * e + 3] = bfhi(q.y);
                kv[8 * e + 4] = bflo(q.z); kv[8 * e + 5] = bfhi(q.z); kv[8 * e + 6] = bflo(q.w); kv[8 * e + 7] = bfhi(q.w); }
        }
        f32x4* ko = (f32x4*)(A.out + O_SK + (((size_t)b * WIN + w) * NKV + kvh) * HD + d0);
#pragma unroll
        for (int e = 0; e < 8; ++e) ko[e] = (f32x4){kv[4 * e], kv[4 * e + 1], kv[4 * e + 2], kv[4 * e + 3]};
        float dt[4] = {0.f, 0.f, 0.f, 0.f};
#pragma unroll
        for (int e = 0; e < 32; ++e) {
#pragma unroll
            for (int gg = 0; gg < 4; ++gg) dt[gg] += sq[gg * 128 + d0 + e] * kv[e];
        }
#pragma unroll
        for (int gg = 0; gg < 4; ++gg) { dt[gg] += swz_xor<1>(dt[gg]); dt[gg] += swz_xor<2>(dt[gg]); }
        const float mine = part == 0 ? dt[0] : part == 1 ? dt[1] : part == 2 ? dt[2] : dt[3];
        sl[part * 128 + w] = mine + A.table[rel_bucket(127 - w) * NH + 4 * kvh + part];
    }
    __syncthreads();
    if (wave < 4) {
        const float sink = A.sinks[4 * kvh + wave];
        const float l0 = sl[wave * 128 + lane], l1 = sl[wave * 128 + 64 + lane];
        const float mx = fmaxf(wave_max(fmaxf(l0, l1)), sink);
        const float e0 = __expf(l0 - mx), e1 = __expf(l1 - mx);
        const float inv = 1.0f / (wave_sum(e0 + e1) + __expf(sink - mx));
        sl[wave * 128 + lane] = e0 * inv; sl[wave * 128 + 64 + lane] = e1 * inv;
    }
    __syncthreads();
    {
        const int d = tid & 127, qt = tid >> 7;
        float acc[4] = {0.f, 0.f, 0.f, 0.f};
#pragma unroll 8
        for (int i = 0; i < 32; ++i) {
            const int w = 32 * qt + i;
            const float v = w < 127 ? A.cache_v[(((size_t)b * WIN + w + 1) * NKV + kvh) * HD + d] : bf2f(A.Z[(size_t)row * DIN + ZC_V + kvh * HD + d]);
            A.out[O_SV + (((size_t)b * WIN + w) * NKV + kvh) * HD + d] = v;
#pragma unroll
            for (int gg = 0; gg < 4; ++gg) acc[gg] += sl[gg * 128 + w] * v;
        }
#pragma unroll
        for (int gg = 0; gg < 4; ++gg) so[(qt * 4 + gg) * 128 + d] = acc[gg];
    }
    __syncthreads();
    { const int gg = tid >> 7, d = tid & 127;
      const float v = so[(0 * 4 + gg) * 128 + d] + so[(1 * 4 + gg) * 128 + d] + so[(2 * 4 + gg) * 128 + d] + so[(3 * 4 + gg) * 128 + d];
      A.MIX[(size_t)row * D + (4 * kvh + gg) * HD + d] = (bf16_t)f2bf(v);
      const float ss = wave_sum(v * v);
      if (lane == 0) atomicAdd(A.ssa + row, ss); }
    __syncthreads();
}

__device__ __forceinline__ void prompt_states(const bf16_t* Z, float* out, int tid) {
    for (int e = tid; e < 32768; e += 512) {
        const int d = e & 127, kvh = (e >> 7) & 1, wi = e >> 8;
        const bf16_t* z = Z + (size_t)tok2row(TP - WIN + wi) * DIN + kvh * HD + d;
        out[O_PK + e] = bf2f(z[ZC_K]); out[O_PV + e] = bf2f(z[ZC_V]);
    }
    for (int e = tid; e < 3072; e += 512) { const int c = e & 1023, j = e >> 10; out[O_PRC + e] = bf2f(Z[(size_t)tok2row(TP - 3 + j) * DIN + ZC_XR + c]); }
}
__device__ __forceinline__ void fixup_elem(bf16_t* ACT, const float* halo, const float* first, const float* cw, const float* cb, float* out, int i) {
    if (i < 128 * 2 * DFF) {
        const int ch = i % DFF, rr = (i / DFF) & 1, q = i / (2 * DFF);
        const int qp = q == 0 ? 128 : q - 1;
        const float h0 = halo[((size_t)qp * 2 + 0) * DFF + ch], h1 = halo[((size_t)qp * 2 + 1) * DFF + ch];
        const float u0 = first[((size_t)(q * 2 + 0) * 2 + 0) * DFF + ch], u1 = first[((size_t)(q * 2 + 1) * 2 + 0) * DFF + ch];
        const float g = first[((size_t)(q * 2 + rr) * 2 + 1) * DFF + ch];
        const float um2 = rr == 0 ? h0 : h1, um1 = rr == 0 ? h1 : u0, uc = rr == 0 ? u0 : u1;
        const float a = gelu_tanh(cb[ch] + cw[ch] * um2 + cw[DFF + ch] * um1 + cw[2 * DFF + ch] * uc) * g;
        ACT[(size_t)(q * 64 + rr) * DFF + ch] = (bf16_t)f2bf(a);
    } else if (i < 128 * 2 * DFF + 2 * DFF) {
        const int e = i - 128 * 2 * DFF;
        out[O_PFC + e] = halo[(size_t)127 * 2 * DFF + e];
    }
}

typedef __attribute__((address_space(1))) unsigned gu32;
#define XB_TMO      128
#define XB_XCNT(j)  (256  + 64 * (j))
#define XB_XSUB(j)  (1280 + 64 * (j))
#define XB_XGEN(j)  (2304 + 64 * (j))
#define XB_TOP      3328
#define XB_TOPGEN   3392
#define XCD_BAR_WORDS 3456
#define XB_SPIN_CAP (1u << 18)

__device__ __forceinline__ unsigned xb_ld(unsigned* p)              { return __hip_atomic_load(p, __ATOMIC_RELAXED, __HIP_MEMORY_SCOPE_AGENT); }
__device__ __forceinline__ unsigned xb_add(unsigned* p, unsigned v) { return __hip_atomic_fetch_add(p, v, __ATOMIC_RELAXED, __HIP_MEMORY_SCOPE_AGENT); }
__device__ __forceinline__ unsigned xb_xcc_id() { return (unsigned)__builtin_amdgcn_s_getreg((3 << 11) | 20) & 0xFu; }
#define XB_SPIN(cond, bar) do { unsigned _sp = 0; while (cond) { __builtin_amdgcn_s_sleep(1); \
    if ((++_sp & 255u) == 0u) { if (xb_ld(&(bar)[XB_TMO])) break; if (_sp > XB_SPIN_CAP) { atomicAdd(&(bar)[XB_TMO], 1u); break; } } } } while (0)

struct XcdBarrier {
    unsigned* bar; unsigned x;
    volatile LAS unsigned* st;
};

__device__ __forceinline__ XcdBarrier xcd_barrier_post(unsigned* bar, volatile LAS unsigned* st) {
    XcdBarrier b; b.bar = bar; b.x = xb_xcc_id(); b.st = st;
    if (threadIdx.x == 0) (void)xb_add(&bar[XB_XCNT(b.x)], 1u);
    return b;
}
__device__ __forceinline__ void xcd_barrier_complete(unsigned* bar, unsigned x, unsigned& nloc, unsigned& nx) {
    const unsigned G = gridDim.x * gridDim.y * gridDim.z;
    unsigned sum, cnt, mine, sp = 0u;
    for (;;) {
        sum = 0u; cnt = 0u; mine = 0u;
#pragma unroll
        for (unsigned j = 0; j < 16; ++j) { const unsigned c = xb_ld(&bar[XB_XCNT(j)]); sum += c; cnt += (c > 0u) ? 1u : 0u; mine = (j == x) ? c : mine; }
        if (sum == G) break;
        __builtin_amdgcn_s_sleep(1);
        if ((++sp & 255u) == 0u) { if (xb_ld(&bar[XB_TMO])) break; if (sp > XB_SPIN_CAP) { atomicAdd(&bar[XB_TMO], 1u); break; } }
    }
    nloc = mine > 0u ? mine : 1u; nx = cnt > 0u ? cnt : 1u;
}

__device__ __forceinline__ void xcd_barrier(const XcdBarrier& b, bool leader) {
    asm volatile("s_waitcnt vmcnt(0)" ::: "memory");
    __syncthreads();
    if (leader) {
        unsigned* bar = b.bar;
        __builtin_amdgcn_s_waitcnt(0);
        unsigned nloc = b.st[0], nx = b.st[1];
        if (nloc == 0u) { xcd_barrier_complete(bar, b.x, nloc, nx); b.st[0] = nloc; b.st[1] = nx; }
        const unsigned old = xb_add(&bar[XB_XSUB(b.x)], 1u);
        const unsigned gen = old / nloc;
        if (old + 1u == (gen + 1u) * nloc) {
            __builtin_amdgcn_fence(__ATOMIC_RELEASE, "agent");
            asm volatile("s_waitcnt vmcnt(0)" ::: "memory");
            const unsigned og = xb_add(&bar[XB_TOP], 1u);
            const unsigned tg = og / nx;
            if (og + 1u == (tg + 1u) * nx) xb_add(&bar[XB_TOPGEN], 1u);
            else XB_SPIN(xb_ld(&bar[XB_TOPGEN]) == tg, bar);
            __builtin_amdgcn_fence(__ATOMIC_ACQUIRE, "agent");
            xb_add(&bar[XB_XGEN(b.x)], 1u);
            asm volatile("s_waitcnt vmcnt(0)" ::: "memory");
        } else {
            XB_SPIN(xb_ld(&bar[XB_XGEN(b.x)]) == gen, bar);
            __builtin_amdgcn_fence(__ATOMIC_ACQUIRE, "agent");
            asm volatile("s_waitcnt vmcnt(0)" ::: "memory");
        }
    }
    __syncthreads();
}


constexpr int SK_ROWS = 144, SK_RB = 9;
template <int CB, class Scale>
__device__ __forceinline__ void skinny_accum(LAS float* tile, const bf16_t* A, int lda, const bf16_t* Wt, int ldw, const int (&wrow)[CB], int k0, int KL, int tid, int wave, int lane, Scale scale) {
    const int wsel = (wave + (int)blockIdx.x) & 7;
    const int fr = lane & 15, fq = lane >> 4, kw = k0 + wsel * (KL >> 3) + 8 * fq, nks = KL >> 8;
    const int ksrot = ((int)blockIdx.x >> 3) % nks;
    f32x4 acc[SK_RB][CB];
#pragma unroll
    for (int rb = 0; rb < SK_RB; ++rb)
#pragma unroll
        for (int cb = 0; cb < CB; ++cb) acc[rb][cb] = (f32x4){0.f, 0.f, 0.f, 0.f};
    const bf16_t* ap = A + (size_t)(ROW_META + fr) * lda + kw;
    const bf16_t* bp[CB];
#pragma unroll
    for (int cb = 0; cb < CB; ++cb) bp[cb] = Wt + (size_t)(wrow[cb] + fr) * ldw + kw;
#pragma unroll 2
    for (int ks0 = 0; ks0 < nks; ++ks0) {
        const int ks = ks0 + ksrot < nks ? ks0 + ksrot : ks0 + ksrot - nks;
        bf16x8 af[SK_RB], bf[CB];
#pragma unroll
        for (int rb = 0; rb < SK_RB; ++rb) af[rb] = __builtin_bit_cast(bf16x8, *(const u32x4*)(ap + (size_t)(16 * rb) * lda + 32 * ks));
#pragma unroll
        for (int cb = 0; cb < CB; ++cb) bf[cb] = __builtin_bit_cast(bf16x8, *(const u32x4*)(bp[cb] + 32 * ks));
#pragma unroll
        for (int rb = 0; rb < SK_RB; ++rb)
#pragma unroll
            for (int cb = 0; cb < CB; ++cb) acc[rb][cb] = __builtin_amdgcn_mfma_f32_16x16x32_bf16(af[rb], bf[cb], acc[rb][cb], 0, 0, 0);
    }
#pragma unroll
    for (int rb = 0; rb < SK_RB; ++rb)
#pragma unroll
        for (int j = 0; j < 4; ++j) {
            const float s = scale(wsel, 16 * rb + 4 * fq + j);
#pragma unroll
            for (int cb = 0; cb < CB; ++cb) acc[rb][cb][j] *= s;
        }
    LAS f32x4* slab = (LAS f32x4*)tile;
    constexpr int SLAB = SK_RB * CB * 64;
#pragma unroll
    for (int half = 4; half >= 1; half >>= 1) {
        if (wave >= half && wave < 2 * half) {
#pragma unroll
            for (int rb = 0; rb < SK_RB; ++rb)
#pragma unroll
                for (int cb = 0; cb < CB; ++cb) slab[(wave - half) * SLAB + (rb * CB + cb) * 64 + lane] = acc[rb][cb];
        }
        __syncthreads();
        if (wave < half) {
#pragma unroll
            for (int rb = 0; rb < SK_RB; ++rb)
#pragma unroll
                for (int cb = 0; cb < CB; ++cb) acc[rb][cb] += slab[wave * SLAB + (rb * CB + cb) * 64 + lane];
        }
        __syncthreads();
    }
    if (wave == 0) {
#pragma unroll
        for (int rb = 0; rb < SK_RB; ++rb)
#pragma unroll
            for (int cb = 0; cb < CB; ++cb) slab[(rb * CB + cb) * 64 + lane] = acc[rb][cb];
    }
    __syncthreads();
}
template <int CB> __device__ __forceinline__ float sk_at(const LAS float* tile, int r, int cb, int c) { return tile[((((r >> 4) * CB + cb) * 64) + ((r & 15) >> 2) * 16 + c) * 4 + (r & 3)]; }
__device__ __forceinline__ void skinny_out(LAS unsigned char* lds, const bf16_t* MIX, const bf16_t* Wt_out, const RowMap& R, const XIn& X, bf16_t* X1b, const float* ssa, float* ss1, int cg, int tid, int wave, int lane) {
    LAS float* tile = (LAS float*)lds;
    const int wrow[1] = {16 * cg};
    skinny_accum<1>(tile, MIX, D, Wt_out, D, wrow, 0, D, tid, wave, lane, [&](int w, int r) { return w < 4 ? 1.0f / sqrtf(ssa[ROW_META + r] * (1.0f / DATT) + EPS) : 1.0f; });
    for (int e = tid; e < SK_ROWS * 16; e += 512) {
        const int r = e >> 4, c = e & 15, row = ROW_META + r, col = 16 * cg + c;
        const float v = xin_ptr(X, row)[col] + sk_at<1>(tile, r, 0, c);
        xrow_ptr(R, row)[col] = v;
        X1b[(size_t)row * D + col] = (bf16_t)f2bf(v);
        float ss = v * v;
        ss += swz_xor<1>(ss); ss += swz_xor<2>(ss); ss += swz_xor<4>(ss); ss += swz_xor<8>(ss);
        if (c == 0) atomicAdd(ss1 + row, ss);
    }
    __syncthreads();
}
__device__ __forceinline__ void skinny_ug(LAS unsigned char* lds, const bf16_t* X1b, const bf16_t* Wt_ug, bf16_t* ACT, const float* ss1, const float* cw, const float* cb, const float* st, float* halo, float* out_sfc,
                                          int cgp, int tid, int wave, int lane) {
    LAS float* tile = (LAS float*)lds;
    const int ch0 = 16 * cgp;
    const int wrow[2] = {256 * (ch0 >> 7) + (ch0 & 127), 256 * (ch0 >> 7) + 128 + (ch0 & 127)};
    skinny_accum<2>(tile, X1b, D, Wt_ug, D, wrow, 0, D, tid, wave, lane, [](int, int) { return 1.0f; });
    for (int e = tid; e < SK_ROWS * 16; e += 512) {
        const int r = e >> 4, c = e & 15, row = ROW_META + r, ch = ch0 + c;
        const float rs = 1.0f / sqrtf(ss1[row] * (1.0f / D) + EPS);
        const float u = sk_at<2>(tile, r, 0, c) * rs, g = sk_at<2>(tile, r, 1, c) * rs;
        if (r >= NMETA) {
            const int b = r - NMETA;
            const float s0 = st[((size_t)b * 2) * DFF + ch], s1 = st[((size_t)b * 2 + 1) * DFF + ch];
            const float a = gelu_tanh(cb[ch] + cw[ch] * s0 + cw[DFF + ch] * s1 + cw[2 * DFF + ch] * u) * g;
            ACT[(size_t)row * DFF + ch] = (bf16_t)f2bf(a);
            out_sfc[((size_t)b * 2) * DFF + ch] = s1; out_sfc[((size_t)b * 2 + 1) * DFF + ch] = u;
        } else if (r >= NMETA - 2) halo[((size_t)128 * 2 + (r - (NMETA - 2))) * DFF + ch] = u;
    }
    __syncthreads();
}
__device__ __forceinline__ void skinny_down(LAS unsigned char* lds, const bf16_t* ACT, const bf16_t* Wt_dn, const RowMap& R, int cg, int khalf, int tid, int wave, int lane) {
    LAS float* tile = (LAS float*)lds;
    const int wrow[1] = {16 * cg};
    skinny_accum<1>(tile, ACT, DFF, Wt_dn, DFF, wrow, khalf * (DFF / 2), DFF / 2, tid, wave, lane, [](int, int) { return 1.0f; });
    for (int e = tid; e < SK_ROWS * 16; e += 512) {
        const int r = e >> 4, c = e & 15;
        if (r >= NMETA) atomicAdd(xrow_ptr(R, ROW_META + r) + 16 * cg + c, sk_at<1>(tile, r, 0, c));
    }
    __syncthreads();
}

constexpr int LDS_BYTES = 147456;
constexpr int MISC_OFF = LDS_BYTES - 256;
static_assert(pg8::STAGE_BYTES <= LDS_BYTES && AT_LDS <= LDS_BYTES, "LDS map");
typedef const __attribute__((address_space(4))) Params* KParams;
__device__ __forceinline__ KParams kparams() { KParams q = (KParams)__builtin_amdgcn_kernarg_segment_ptr(); asm volatile("" : "+s"(q)); return q; }
#define PHASE_BEGIN() \
    KParams p = kparams(); \
    int wave = wave_s; asm volatile("" : "+s"(wave)); const int lane = fresh_lane(); const int tid = wave * 64 + lane; (void)tid; \
    unsigned char* ws = p->ws; float* out = p->out; (void)out; \
    bf16_t *Wt_in = (bf16_t*)(ws + WS_WIN), *Wt_out = (bf16_t*)(ws + WS_WOUT), *Wt_ug = (bf16_t*)(ws + WS_WUG), *Wt_dn = (bf16_t*)(ws + WS_WDN); (void)Wt_in; (void)Wt_out; (void)Wt_ug; (void)Wt_dn; \
    bf16_t *H0 = (bf16_t*)(ws + WS_H0), *Z = (bf16_t*)(ws + WS_Z), *MIX = (bf16_t*)(ws + WS_MIX), *ACT = (bf16_t*)(ws + WS_ACT), *X1b = (bf16_t*)(ws + WS_X1B); (void)H0; (void)Z; (void)MIX; (void)ACT; (void)X1b; \
    float *XS = (float*)(ws + WS_XS), *ssa = (float*)(ws + WS_SSA), *ss1 = (float*)(ws + WS_RS1), *halo = (float*)(ws + WS_HALO), *first = (float*)(ws + WS_FIRST); (void)ssa; (void)ss1; (void)halo; (void)first; \
    XIn X; X.xp = p->x_prompt; X.meta = p->meta; X.xsamp = p->x_sample; (void)X; \
    RowMap R; R.out = out; R.xs = XS; (void)R
#define SCAN_IN() ScanIn SI; SI.Z = Z; SI.R = R; SI.MIX = MIX; SI.st_conv = p->st_conv; SI.st_h = p->st_h; SI.conv_w = p->conv_w; SI.conv_b = p->conv_b; SI.ga_b = p->ga_b; SI.gx_b = p->gx_b; SI.lam = p->lam; \
    SI.gwf = (const u32x4*)(ws + WS_GWF); SI.sumA = (float*)(ws + WS_SUMA); SI.sumB = (float*)(ws + WS_SUMB); SI.sumHA = (float*)(ws + WS_SUMHA); SI.sumHB = (float*)(ws + WS_SUMHB); \
    SI.oma = (bf16_t*)(out + O_Y); SI.bb = SI.oma + (size_t)MP * DRNN; SI.out = out

__global__ void __launch_bounds__(512, 2) mega(Params p_unused) {
    extern __shared__ __attribute__((aligned(16))) unsigned char lds_raw[];
    LAS unsigned char* lds = (LAS unsigned char*)lds_raw;
    const int bid = blockIdx.x, G = gridDim.x;
    const int wave_s = __builtin_amdgcn_readfirstlane(threadIdx.x >> 6);
    volatile LAS unsigned* MISC = (volatile LAS unsigned*)(lds + MISC_OFF);
    if (threadIdx.x < 64) MISC[threadIdx.x] = 0u;
    __syncthreads();
    XcdBarrier bar;
    { KParams p = kparams(); bar = xcd_barrier_post((unsigned*)(p->ws + WS_CTL), MISC + 8); }

    {
        PHASE_BEGIN();
        WPrep W; W.w_in = p->w_in; W.w_out = p->w_out; W.w_up = p->w_up; W.w_gate = p->w_gate; W.w_down = p->w_down; W.g_mix = p->norm_mix; W.g_rnn = p->norm_rnn; W.g_attn = p->norm_attn; W.g_ffn = p->norm_ffn;
        W.t_in = Wt_in; W.t_out = Wt_out; W.t_ug = Wt_ug; W.t_dn = Wt_dn;
        const int half = tid >> 8;
        LAS float* s = (LAS float*)(lds + half * 16896);
        {
            const int t256 = tid & 255;
            int it = 2 * bid + half;
            f32x4 cur[4];
            WTile tc = wprep_decode(W, it < WT_TOTAL ? it : 0);
            if (it < WT_TOTAL) wprep_load(tc, t256, cur);
            while (it < WT_TOTAL) {
                const int nx = it + 2 * G;
                f32x4 nxt[4];
                const WTile tn = wprep_decode(W, nx < WT_TOTAL ? nx : it);
                wprep_load(tn, t256, nxt);
                wprep_store(W, tc, t256, cur, s);
#pragma unroll
                for (int i = 0; i < 4; ++i) cur[i] = nxt[i];
                tc = tn; it = nx;
            }
        }
        for (int i = bid * 512 + tid; i < 16384; i += G * 512) prep_gwf_frag(p->ga_w, p->gx_w, (u32x4*)(ws + WS_GWF), i);
        for (int row = bid * 8 + wave; row < MP; row += G * 8) prep_row(X, H0, row, lane);
        for (int i = bid * 512 + tid; i < 2 * MP; i += G * 512) ssa[i] = 0.f;
    }
    xcd_barrier(bar, wave_s == 0 && fresh_lane() == 0);
    {
        PHASE_BEGIN();
        Gemm g; g.A = H0; g.Bt = Wt_in; g.M = MP; g.N = DIN; g.K = D;
        pg8::StaticOrder S; S.init(MP, DIN, G, bid);
        pg8::EpiZ E; E.O = Z; E.ldc = DIN;
        pg8::gemm_phase<pg8::EpiZ, pg8::StaticOrder, true, true>(lds, g, S, E, tid);
    }
    xcd_barrier(bar, wave_s == 0 && fresh_lane() == 0);
    {
        PHASE_BEGIN();
        SCAN_IN();
        AttnIn A; A.Z = Z; A.MIX = MIX; A.ssa = ssa; A.cache_k = p->cache_k; A.cache_v = p->cache_v; A.sinks = p->sinks; A.table = p->table; A.out = out;
        for (int it = bid; it < 2 * N_QB; it += G) attn_prompt_unit(A, lds, it & 1, it >> 1, tid);
        for (int it = bid; it < 2 * NSAMP; it += G) attn_sample_item(A, lds, it >> 1, it & 1, tid);
        for (int it = (bid + G - (120 % G)) % G; it < 4; it += G) rglru_sample_out(SI, lds, it, wave, lane);
        for (int it = G - 1 - bid; it < 2 * NCHUNK; it += G) rglru_passA(SI, (2 * NCHUNK - 1 - it) >> 1, (2 * NCHUNK - 1 - it) & 1, wave, lane);
        if (bid == (G > 2 ? 2 : 0)) prompt_states(Z, out, tid);
    }
    xcd_barrier(bar, wave_s == 0 && fresh_lane() == 0);
    {
        PHASE_BEGIN();
        SCAN_IN();
        for (int it = bid; it < 129; it += G) rglru_passB(SI, lds, 128 - it, wave, lane);
    }
    xcd_barrier(bar, wave_s == 0 && fresh_lane() == 0);
    {
        PHASE_BEGIN();
        Gemm g; g.A = MIX; g.Bt = Wt_out; g.M = NBIG; g.N = D; g.K = D;
        pg8::StaticOrder S; S.init(NBIG, D, G, bid);
        pg8::EpiOut E; E.R = R; E.X = X; E.X1b = X1b; E.ssa = ssa; E.ss1 = ss1;
        pg8::gemm_phase<pg8::EpiOut, pg8::StaticOrder, true, true>(lds, g, S, E, tid);
        { const int lane2 = fresh_lane(), tid2 = wave * 64 + lane2;
          for (int it = bid; it < D / 16; it += G) skinny_out(lds, MIX, Wt_out, R, X, X1b, ssa, ss1, it, tid2, wave, lane2); }
    }
    xcd_barrier(bar, wave_s == 0 && fresh_lane() == 0);
    {
        PHASE_BEGIN();
        Gemm g; g.A = X1b; g.Bt = Wt_ug; g.M = NBIG; g.N = 2 * DFF; g.K = D;
        pg8::StaticOrder S; S.init(NBIG, 2 * DFF, G, bid);
        pg8::EpiUG E; E.ws = ws; E.o_act = WS_ACT; E.o_ss1 = WS_RS1; E.o_halo = WS_HALO; E.o_first = WS_FIRST; E.cw = p->fconv_w; E.cb = p->fconv_b; E.st = p->st_ffn; E.out_sfc = out + O_SFC;
        pg8::gemm_phase<pg8::EpiUG, pg8::StaticOrder, true, true>(lds, g, S, E, tid);
        { const int lane2 = fresh_lane(), tid2 = wave * 64 + lane2;
          for (int it = bid; it < DFF / 16; it += G) skinny_ug(lds, X1b, Wt_ug, ACT, ss1, p->fconv_w, p->fconv_b, p->st_ffn, halo, out + O_SFC, it, tid2, wave, lane2); }
    }
    xcd_barrier(bar, wave_s == 0 && fresh_lane() == 0);
    {
        PHASE_BEGIN();
        Gemm g; g.A = ACT; g.Bt = Wt_dn; g.M = NBIG; g.N = D; g.K = DFF;
        pg8::StaticOrder S; S.init(NBIG, D, G, bid);
        pg8::Unit u;
        for (int i = 0; S.next(i, u); ++i)
            if (u.pm < NBIG / 256)
                for (int e = tid; e < 8 * DFF; e += 512) fixup_elem(ACT, halo, first, p->fconv_w, p->fconv_b, out, (8 * u.pm) * DFF + e);
        if (bid == 0) for (int e = tid; e < 2 * DFF; e += 512) fixup_elem(ACT, halo, first, p->fconv_w, p->fconv_b, out, 128 * 2 * DFF + e);
        asm volatile("s_waitcnt vmcnt(0)" ::: "memory");
        __syncthreads();
        pg8::EpiRes E; E.R = R; E.X = X; E.mode = 1; E.pad_ = 0;
        pg8::gemm_phase<pg8::EpiRes, pg8::StaticOrder, true, true>(lds, g, S, E, tid);
        { const int lane2 = fresh_lane(), tid2 = wave * 64 + lane2;
          for (int it = bid; it < 2 * (D / 16); it += G) skinny_down(lds, ACT, Wt_dn, R, it >> 1, it & 1, tid2, wave, lane2); }
    }
    xcd_barrier(bar, wave_s == 0 && fresh_lane() == 0);
    {
        PHASE_BEGIN();
        for (int r = bid * 8 + wave; r < NBIG + NSAMP; r += G * 8) final_row(out, p->norm_final, r, lane);
    }
}

extern "C" void kernel_launch(void* const* d_in, const int* in_sizes, int n_in, void* d_out, int out_size, void* d_ws, size_t ws_size, hipStream_t stream) {
    static int grid = 0;
    if (ws_size < WS_END) return;
    if (grid == 0) {
        if (n_in != 29 || out_size != (int)O_END || ws_size < WS_END) fprintf(stderr, "kernel_launch: unexpected shapes n_in %d out %d ws %zu (need %zu)\n", n_in, out_size, ws_size, (size_t)WS_END);
        int dev = 0, cus = 0, per_cu = 0;
        (void)hipGetDevice(&dev);
        (void)hipDeviceGetAttribute(&cus, hipDeviceAttributeMultiprocessorCount, dev);
        (void)hipFuncSetAttribute((const void*)mega, hipFuncAttributeMaxDynamicSharedMemorySize, LDS_BYTES);
        (void)hipOccupancyMaxActiveBlocksPerMultiprocessor(&per_cu, (const void*)mega, 512, LDS_BYTES);
        if (per_cu < 1) { fprintf(stderr, "kernel_launch: occupancy query says %d blocks per CU\n", per_cu); per_cu = 1; }
        grid = cus * per_cu;
        if (grid <= 0) grid = 256;
    }
    Params p; memset(&p, 0, sizeof p);
    const float* const* in = (const float* const*)d_in;
    p.x_prompt = in[0]; p.x_sample = in[1]; p.st_conv = in[2]; p.st_h = in[3]; p.cache_k = in[4]; p.cache_v = in[5]; p.st_ffn = in[6]; p.meta = in[7]; p.table = in[8];
    p.norm_mix = in[9]; p.w_in = in[10]; p.conv_w = in[11]; p.conv_b = in[12]; p.ga_w = in[13]; p.ga_b = in[14]; p.gx_w = in[15]; p.gx_b = in[16]; p.lam = in[17]; p.sinks = in[18];
    p.norm_rnn = in[19]; p.norm_attn = in[20]; p.w_out = in[21]; p.norm_ffn = in[22]; p.w_up = in[23]; p.w_gate = in[24]; p.fconv_w = in[25]; p.fconv_b = in[26]; p.w_down = in[27]; p.norm_final = in[28];
    p.out = (float*)d_out; p.ws = (unsigned char*)d_ws;
    (void)hipMemsetAsync((unsigned char*)d_ws + WS_CTL, 0, 16384, stream);
    void* args[] = {&p};
    hipError_t e = hipLaunchCooperativeKernel((const void*)mega, dim3(grid), dim3(512), args, LDS_BYTES, stream);
    if (e != hipSuccess) fprintf(stderr, "kernel_launch: cooperative launch failed: %s (grid %d)\n", hipGetErrorString(e), grid);
}
```
